# Optimizing an MI355X kernel written in HIP

```python
import math
import jax, jax.numpy as jnp
from jax import lax
import numpy as np

D_MODEL = 2048
BATCH = 1
SEQ = 8192
DEPTH = 4

HEAD_DIM = 128
N_MIX_HEADS = D_MODEL // HEAD_DIM
A_HEADS = 3 * N_MIX_HEADS // 4
A_WIDTH = A_HEADS * HEAD_DIM
B_GROUPS = N_MIX_HEADS - A_HEADS
B_GROUP_DIM = HEAD_DIM
B_WIDTH = B_GROUPS * B_GROUP_DIM
EVEN_IN_WIDTH = 3 * A_WIDTH + B_WIDTH
DILATED_CONFIGS = ((128, 1), (512, 4), (2048, 16))
C_HEADS = D_MODEL // (2 * HEAD_DIM)
C_QK_WIDTH = C_HEADS * 2 * HEAD_DIM
C_V_DIM = 2 * HEAD_DIM
ODD_IN_WIDTH = 2 * C_QK_WIDTH + C_HEADS * C_V_DIM
D_FF = 4 * D_MODEL
NUM_BUCKETS = 32
MAX_DISTANCE = 1024
BIAS_HEADS = A_HEADS + C_HEADS
Q_BLOCK = 128
NORM_EPS = 1e-6
NEG_INF = -1e30
N_EVEN = (DEPTH + 1) // 2
N_ODD = DEPTH // 2

kernel_name = "hybrid_dilated_fourier_diffattn_encoder"


def rmsnorm(x, g):
    xf = x.astype(jnp.float32)
    y = xf * lax.rsqrt(jnp.mean(xf * xf, axis=-1, keepdims=True) + NORM_EPS)
    return (y * g.astype(jnp.float32)).astype(x.dtype)


def t5_bucket(rel):
    half = NUM_BUCKETS // 2
    base = jnp.where(rel > 0, half, 0)
    n = jnp.abs(rel)
    max_exact = half // 2
    nf = jnp.maximum(n, 1).astype(jnp.float32)
    large = max_exact + (jnp.log(nf / max_exact) / math.log(MAX_DISTANCE / max_exact)
                         * (half - max_exact)).astype(jnp.int32)
    large = jnp.minimum(large, half - 1)
    return base + jnp.where(n < max_exact, n, large)


def dilated_branch(q, k, v, table_a, window, dil):
    B, S, H, Dh = q.shape
    half = window // (2 * dil)
    qb = half
    L = S // dil
    nb = -(-L // qb)
    Lp = nb * qb

    def to_cls(t):
        t = t.reshape(B, L, dil, H, Dh).transpose(0, 2, 1, 3, 4)
        return jnp.pad(t, ((0, 0), (0, 0), (0, Lp - L), (0, 0), (0, 0)))

    def band(t):
        tp = jnp.pad(t, ((0, 0), (0, 0), (qb, qb), (0, 0), (0, 0)))
        tp = tp.reshape(B, dil, nb + 2, qb, H, Dh)
        return jnp.concatenate([tp[:, :, :-2], tp[:, :, 1:-1], tp[:, :, 2:]], axis=3)

    qblk = to_cls(q).reshape(B, dil, nb, qb, H, Dh)
    kband = band(to_cls(k))
    vband = band(to_cls(v)).astype(jnp.float32)

    qi = jnp.arange(qb)
    kj = jnp.arange(3 * qb)
    rel = kj[None, :] - qb - qi[:, None]
    t_key = jnp.arange(nb)[:, None] * qb + kj[None, :] - qb
    key_ok = (t_key >= 0) & (t_key < L)
    mask = (jnp.abs(rel) <= half)[None] & key_ok[:, None, :]
    bias = table_a.astype(jnp.float32)[t5_bucket(rel * dil)].transpose(2, 0, 1)

    logits = jnp.einsum('bcnqhd,bcnkhd->bcnhqk', qblk, kband).astype(jnp.float32)
    logits = logits * (1.0 / math.sqrt(Dh)) + bias[None, None, None]
    logits = jnp.where(mask[None, None, :, None], logits, NEG_INF)
    m = jnp.max(logits, axis=-1, keepdims=True)
    p = jnp.exp(logits - m)
    den = jnp.sum(p, axis=-1)
    o = jnp.einsum('bcnhqk,bcnkhd->bcnqhd', p, vband)
    o = o / den.transpose(0, 1, 2, 4, 3)[..., None]
    lse = (m[..., 0] + jnp.log(den)).transpose(0, 1, 2, 4, 3)

    o = o.reshape(B, dil, Lp, H, Dh)[:, :, :L].transpose(0, 2, 1, 3, 4).reshape(B, S, H, Dh)
    lse = lse.reshape(B, dil, Lp, H)[:, :, :L].transpose(0, 2, 1, 3).reshape(B, S, H)
    return o, lse


def dilated_attention(q, k, v, table_a):
    outs, lses = [], []
    for window, dil in DILATED_CONFIGS:
        o, l = dilated_branch(q, k, v, table_a, window, dil)
        outs.append(o)
        lses.append(l)
    w = jax.nn.softmax(jnp.stack(lses, axis=0), axis=0)
    return jnp.sum(w[..., None] * jnp.stack(outs, axis=0), axis=0)


def fourier_mix(u, w_f):
    B, S, _ = u.shape
    g = u.reshape(B, S, B_GROUPS, B_GROUP_DIM).astype(jnp.float32)
    f = jnp.fft.fft2(g, axes=(1, 3), norm='ortho').real
    return jnp.einsum('bsgc,gce->bsge', f, w_f.astype(jnp.float32)).reshape(B, S, B_WIDTH)


def even_mixer(h, w_in, w_f, w_out, table):
    B, S, _ = h.shape
    proj = h @ w_in
    qa = proj[..., :A_WIDTH].reshape(B, S, A_HEADS, HEAD_DIM)
    ka = proj[..., A_WIDTH:2 * A_WIDTH].reshape(B, S, A_HEADS, HEAD_DIM)
    va = proj[..., 2 * A_WIDTH:3 * A_WIDTH].reshape(B, S, A_HEADS, HEAD_DIM)
    ub = proj[..., 3 * A_WIDTH:]
    oa = dilated_attention(qa, ka, va, table[:, :A_HEADS]).reshape(B, S, A_WIDTH)
    ob = fourier_mix(ub, w_f)
    return jnp.concatenate([oa, ob], axis=-1).astype(h.dtype) @ w_out


def diff_attention(h, w_qkv, w_out, lq1, lk1, lq2, lk2, subln_g, table, layer_idx):
    B, S, _ = h.shape
    lambda_init = 0.8 - 0.6 * math.exp(-0.3 * layer_idx)
    proj = h @ w_qkv
    q = proj[..., :C_QK_WIDTH].reshape(B, S, C_HEADS, 2, HEAD_DIM)
    k = proj[..., C_QK_WIDTH:2 * C_QK_WIDTH].reshape(B, S, C_HEADS, 2, HEAD_DIM)
    v = proj[..., 2 * C_QK_WIDTH:].reshape(B, S, C_HEADS, C_V_DIM).astype(jnp.float32)
    f32 = jnp.float32
    lam = (jnp.exp(jnp.sum(lq1.astype(f32) * lk1.astype(f32)))
           - jnp.exp(jnp.sum(lq2.astype(f32) * lk2.astype(f32))) + lambda_init)
    table_c = table[:, A_HEADS:].astype(f32)
    nqb = S // Q_BLOCK
    qblocks = jnp.moveaxis(q.reshape(B, nqb, Q_BLOCK, C_HEADS, 2, HEAD_DIM), 1, 0)
    kpos = jnp.arange(S)
    scale = 1.0 / math.sqrt(HEAD_DIM)

    def one_block(args):
        qb, i = args
        qpos = i * Q_BLOCK + jnp.arange(Q_BLOCK)
        rel = kpos[None, :] - qpos[:, None]
        bias = table_c[t5_bucket(rel)].transpose(2, 0, 1)
        logits = jnp.einsum('bqhcd,bkhcd->bhcqk', qb, k).astype(f32) * scale
        p = jax.nn.softmax(logits + bias[None, :, None], axis=-1)
        a = p[:, :, 0] - lam * p[:, :, 1]
        return jnp.einsum('bhqk,bkhe->bqhe', a, v)

    o = lax.map(one_block, (qblocks, jnp.arange(nqb)))
    o = jnp.moveaxis(o, 0, 1).reshape(B, S, C_HEADS, C_V_DIM)
    o = rmsnorm(o, subln_g) * (1.0 - lambda_init)
    return o.reshape(B, S, C_HEADS * C_V_DIM).astype(h.dtype) @ w_out


def sqrelu_mlp(h, w1, w2):
    return jnp.square(jax.nn.relu(h @ w1)) @ w2


def setup_inputs(seed: int = 0) -> dict:
    key = jax.random.key(seed)
    ks = jax.random.split(key, 20)
    f32 = jnp.float32
    nrm = lambda k, shape, s: jax.random.normal(k, shape, f32) * s
    return {
        'x': nrm(ks[0], (BATCH, SEQ, D_MODEL), 1.0),
        'norm_mix_g': 1.0 + nrm(ks[1], (DEPTH, D_MODEL), 0.02),
        'norm_ffn_g': 1.0 + nrm(ks[2], (DEPTH, D_MODEL), 0.02),
        'norm_final_g': 1.0 + nrm(ks[3], (D_MODEL,), 0.02),
        'rel_bias_table': nrm(ks[4], (NUM_BUCKETS, BIAS_HEADS), 0.3),
        'w_in_even': nrm(ks[5], (N_EVEN, D_MODEL, EVEN_IN_WIDTH), D_MODEL ** -0.5),
        'w_fnet': nrm(ks[6], (N_EVEN, B_GROUPS, B_GROUP_DIM, B_GROUP_DIM), B_GROUP_DIM ** -0.5),
        'w_out_even': nrm(ks[7], (N_EVEN, D_MODEL, D_MODEL), D_MODEL ** -0.5),
        'w_qkv_odd': nrm(ks[8], (N_ODD, D_MODEL, ODD_IN_WIDTH), D_MODEL ** -0.5),
        'lambda_q1': nrm(ks[9], (N_ODD, HEAD_DIM), 0.1),
        'lambda_k1': nrm(ks[10], (N_ODD, HEAD_DIM), 0.1),
        'lambda_q2': nrm(ks[11], (N_ODD, HEAD_DIM), 0.1),
        'lambda_k2': nrm(ks[12], (N_ODD, HEAD_DIM), 0.1),
        'subln_g': 1.0 + nrm(ks[13], (N_ODD, C_V_DIM), 0.02),
        'w_out_odd': nrm(ks[14], (N_ODD, D_MODEL, D_MODEL), D_MODEL ** -0.5),
        'w_ff1': nrm(ks[15], (DEPTH, D_MODEL, D_FF), D_MODEL ** -0.5),
        'w_ff2': nrm(ks[16], (DEPTH, D_FF, D_MODEL), 0.5 * D_FF ** -0.5),
    }


def reference(x, norm_mix_g, norm_ffn_g, norm_final_g, rel_bias_table, w_in_even, w_fnet,
              w_out_even, w_qkv_odd, lambda_q1, lambda_k1, lambda_q2, lambda_k2, subln_g,
              w_out_odd, w_ff1, w_ff2):
    for i in range(DEPTH):
        h = rmsnorm(x, norm_mix_g[i])
        j = i // 2
        if i % 2 == 0:
            x = x + even_mixer(h, w_in_even[j], w_fnet[j], w_out_even[j], rel_bias_table)
        else:
            x = x + diff_attention(h, w_qkv_odd[j], w_out_odd[j], lambda_q1[j], lambda_k1[j],
                                   lambda_q2[j], lambda_k2[j], subln_g[j], rel_bias_table, i)
        x = x + sqrelu_mlp(rmsnorm(x, norm_ffn_g[i]), w_ff1[i], w_ff2[i])
    return rmsnorm(x, norm_final_g)
```

```cpp
#include <hip/hip_runtime.h>
#include <hip/hip_bf16.h>
#include <hip/hip_cooperative_groups.h>
#include <cstdio>
#include <cstdint>
namespace cg = cooperative_groups;

namespace pg8 {
#define PG8_LAS __attribute__((address_space(3)))
typedef unsigned short bf16_t;
typedef short bf16x8 __attribute__((ext_vector_type(8)));
typedef float f32x4 __attribute__((ext_vector_type(4)));
typedef unsigned u32x4 __attribute__((ext_vector_type(4)));
constexpr int BM = 256, BK = 64, HALF = 128, HTB = HALF * BK * 2  , STAGE_BYTES = 8 * HTB, NXCD = 8, WGM = 8;

__host__ __device__ __forceinline__ int lds_byte(int r, int c) { const int st = (r >> 4) * 2 + (c >> 5), rr = r & 15, cc = c & 31, ob = rr * 64 + cc * 2; return st * 1024 + (ob ^ (((ob >> 9) & 1) << 5)); }
__host__ __device__ __forceinline__ void stage_rc(int b, int& R, int& C) { const int st = b / 1024, sb = b % 1024, swz = sb ^ (((sb >> 9) & 1) << 5); R = (st >> 1) * 16 + swz / 64; C = (st & 1) * 32 + (swz % 64) / 2; }
__host__ __device__ __forceinline__ int perm32(int rho) { const int n = rho >> 4, i = rho & 15; return 8 * (i >> 2) + 4 * n + (i & 3); }

struct Unit { int pm, pn, kc; };
struct Gemm { const bf16_t* A; const bf16_t* Bt; int lda, ldb, K; int bsplit_pm = 1 << 30; int bsplit_off = 0; };

struct Order {
    int nM, nN, nK, nwg, tot, G, c;
    __device__ void init(int M, int N, int nK_, int G_, int c_) { nM = M / BM; nN = N / BM; nK = nK_; nwg = nM * nN; tot = nwg * nK; G = G_; c = c_; }
    __device__ bool next(int i, Unit& u) const {
        const long L = (long)i * G + c; if (L >= tot) return false;
        const int kc = (int)(L / nwg); int wgid = (int)(L % nwg);
        { const int q = nwg / NXCD, r = nwg % NXCD, xcd = wgid % NXCD, off = wgid / NXCD; wgid = (xcd < r ? xcd * (q + 1) : r * (q + 1) + (xcd - r) * q) + off; }
        const int nig = WGM * nN, gid = wgid / nig, fm = gid * WGM, gsz = (nM - fm) < WGM ? (nM - fm) : WGM;
        u.pm = fm + ((wgid % nig) % gsz); u.pn = (wgid % nig) / gsz; u.kc = kc; return true;
    }
    __device__ __forceinline__ void a_ready(const Unit&) const {}
    __device__ __forceinline__ void done(const Unit&) const {}
};

__device__ __forceinline__ unsigned cvt_pk_bf16(float lo, float hi) { unsigned r; asm volatile("v_cvt_pk_bf16_f32 %0, %1, %2" : "=v"(r) : "v"(lo), "v"(hi)); return r; }

template <int ACT, bool YSPLIT> struct EpiBf16 {
    static constexpr bool PERM = true, AFTER_DRAIN = false;
    bf16_t* O; int ldc; int ysplit_cols;
    __device__ __forceinline__ void operator()(const f32x4 (&acc)[2][2][4][2], const Unit& u, int wr, int wc, int fr, int fq) const {
        int rowt = u.pm * BM, colt = u.pn * BM;
        if (YSPLIT) { rowt = (u.pm & 1) * BM; colt = (u.pn >> 4) * (2 * ysplit_cols) + (u.pm >> 1) * ysplit_cols + (u.pn & 15) * BM; }
        const int row0 = rowt + wr * 64 + fr; const int col0 = colt + wc * 32 + 8 * fq;
#pragma unroll
        for (int ai = 0; ai < 2; ++ai)
#pragma unroll
            for (int m = 0; m < 4; ++m) { bf16_t* rowp = O + (size_t)(row0 + ai * HALF + m * 16) * ldc + col0;
#pragma unroll
                for (int bj = 0; bj < 2; ++bj) { f32x4 v0 = acc[ai][bj][m][0], v1 = acc[ai][bj][m][1];
                    if (ACT == 2) {
#pragma unroll
                        for (int q = 0; q < 4; ++q) { const float a = fmaxf(v0[q], 0.f), b = fmaxf(v1[q], 0.f); v0[q] = a * a; v1[q] = b * b; } }
                    u32x4 w; w.x = cvt_pk_bf16(v0[0], v0[1]); w.y = cvt_pk_bf16(v0[2], v0[3]); w.z = cvt_pk_bf16(v1[0], v1[1]); w.w = cvt_pk_bf16(v1[2], v1[3]);
                    *(u32x4*)(rowp + bj * HALF) = w; } }
    }
};
struct EpiRes {
    static constexpr bool PERM = true, AFTER_DRAIN = false;
    const float* base; float* out; int ldc;
    __device__ __forceinline__ void operator()(const f32x4 (&acc)[2][2][4][2], const Unit& u, int wr, int wc, int fr, int fq) const {
        const int col0 = u.pn * BM + wc * 32 + 8 * fq;
#pragma unroll
        for (int ai = 0; ai < 2; ++ai)
#pragma unroll
            for (int m = 0; m < 4; ++m) { const size_t off = (size_t)(u.pm * BM + ai * HALF + wr * 64 + m * 16 + fr) * ldc + col0;
#pragma unroll
                for (int bj = 0; bj < 2; ++bj) { const f32x4 b0 = *(const f32x4*)(base + off + bj * HALF), b1 = *(const f32x4*)(base + off + bj * HALF + 4);
                    *(f32x4*)(out + off + bj * HALF) = b0 + acc[ai][bj][m][0]; *(f32x4*)(out + off + bj * HALF + 4) = b1 + acc[ai][bj][m][1]; }
                asm volatile("" ::: "memory"); }
    }
};
struct EpiPart {
    static constexpr bool PERM = true, AFTER_DRAIN = false;
    float* out; int ldc; size_t kstride;
    __device__ __forceinline__ void operator()(const f32x4 (&acc)[2][2][4][2], const Unit& u, int wr, int wc, int fr, int fq) const {
        const int col0 = u.pn * BM + wc * 32 + 8 * fq; float* o = out + (size_t)u.kc * kstride;
#pragma unroll
        for (int ai = 0; ai < 2; ++ai)
#pragma unroll
            for (int m = 0; m < 4; ++m) { const int r = u.pm * BM + ai * HALF + wr * 64 + m * 16 + fr; const size_t off = (size_t)(((r & 4095) << 1) | (r >> 12)) * ldc + col0;
#pragma unroll
                for (int bj = 0; bj < 2; ++bj) { *(f32x4*)(o + off + bj * HALF) = acc[ai][bj][m][0]; *(f32x4*)(o + off + bj * HALF + 4) = acc[ai][bj][m][1]; } }
    }
};

template <class Epi, class Sched, bool ALIGN_EPI = false, bool SP2 = false>
__device__ __forceinline__ void gemm_phase(PG8_LAS unsigned char* lds, const Gemm g, const Sched& S, const Epi& E) {
    int tid_ = threadIdx.x; asm volatile("" : "+v"(tid_));
    const int tid = tid_, wid = __builtin_amdgcn_readfirstlane(tid >> 6), lane = tid & 63, wr = wid >> 2, wc = wid & 3, fr = lane & 15, fq = lane >> 4;
    const int K = g.K, nt = K / BK;
    unsigned voffA[2], voffB[2];
#pragma unroll
    for (int i = 0; i < 2; ++i) { int R, C; stage_rc(tid * 16 + i * 8192, R, C); const int Rb = Epi::PERM ? ((R & ~31) + perm32(R & 31)) : R;
        voffA[i] = (unsigned)(R * g.lda + C) * 2u; voffB[i] = (unsigned)(Rb * g.ldb + C) * 2u; }
    const size_t kstep = (size_t)(BK * 2);
    const size_t hstepA = (size_t)HALF * g.lda * 2, hstepB = (size_t)HALF * g.ldb * 2;
    const size_t tstepA = 2 * hstepA, tstepB = 2 * hstepB; const size_t ksplit = (size_t)K * 2;
    const unsigned ldsw = (unsigned)wid * 1024u;
    const int aoff = lds_byte(wr * 64 + fr, fq * 8), boff = lds_byte(wc * 32 + fr, fq * 8);
#define PG8_SA(b, h) (((b) * 2 + (h)) * HTB)
#define PG8_SB(b, h) ((4 + (b) * 2 + (h)) * HTB)
#define PG8_STAGE(bufoff, gbase, voff) do { _Pragma("unroll") for (int _i = 0; _i < 2; ++_i) \
        __builtin_amdgcn_global_load_lds((const unsigned*)((const char*)(gbase) + (voff)[_i]), (PG8_LAS unsigned*)(lds + (bufoff) + ldsw + _i * 8192), 16, 0, 0); } while (0)
#define PG8_LDA(dst, b, h) do { _Pragma("unroll") for (int m = 0; m < 4; ++m) _Pragma("unroll") for (int k = 0; k < 2; ++k) dst[m][k] = *(const PG8_LAS bf16x8*)(lds + PG8_SA(b, h) + aoff + m * 2048 + k * 1024); } while (0)
#define PG8_LDB(dst, b, h) do { _Pragma("unroll") for (int n = 0; n < 2; ++n) _Pragma("unroll") for (int k = 0; k < 2; ++k) dst[n][k] = *(const PG8_LAS bf16x8*)(lds + PG8_SB(b, h) + boff + n * 2048 + k * 1024); } while (0)
#define PG8_MMA(ai, bj, At, Bt) do { __builtin_amdgcn_s_setprio(1); _Pragma("unroll") for (int m = 0; m < 4; ++m) _Pragma("unroll") for (int n = 0; n < 2; ++n) _Pragma("unroll") for (int k = 0; k < 2; ++k) \
        acc[ai][bj][m][n] = __builtin_amdgcn_mfma_f32_16x16x32_bf16(Bt[n][k], At[m][k], acc[ai][bj][m][n], 0, 0, 0); __builtin_amdgcn_s_setprio(0); } while (0)
#define PG8_WAIT_V(n) asm volatile("s_waitcnt vmcnt(" #n ")" ::: "memory")
#define PG8_WAIT_L(n) asm volatile("s_waitcnt lgkmcnt(" #n ")" ::: "memory")
#define PG8_BAR __builtin_amdgcn_s_barrier()
#define PG8_SCHED __builtin_amdgcn_sched_barrier(0)
    Unit cur, nxt; int ui = 0;
    if (!S.next(0, cur)) return;
    f32x4 acc[2][2][4][2];
#pragma unroll
    for (int a = 0; a < 2; ++a)
#pragma unroll
        for (int b = 0; b < 2; ++b)
#pragma unroll
            for (int m = 0; m < 4; ++m)
#pragma unroll
                for (int n = 0; n < 2; ++n) acc[a][b][m][n] = (f32x4){0.f, 0.f, 0.f, 0.f};
    bf16x8 At[4][2], B0[2][2], B1[2][2];
    const char* cA = (const char*)g.A + (size_t)cur.pm * tstepA + (size_t)cur.kc * ksplit; const char* cB = (const char*)g.Bt + (size_t)cur.pn * tstepB + (size_t)cur.kc * ksplit + (cur.pm >= g.bsplit_pm ? (size_t)g.bsplit_off * 2 : (size_t)0);
    S.a_ready(cur);
    if constexpr (SP2) {
        PG8_STAGE(PG8_SB(0, 0), cB, voffB); PG8_STAGE(PG8_SB(0, 1), cB + hstepB, voffB); PG8_STAGE(PG8_SA(0, 0), cA, voffA); PG8_STAGE(PG8_SA(0, 1), cA + hstepA, voffA);
        if (wr == 1) PG8_BAR;
        PG8_WAIT_V(2); PG8_BAR;
        PG8_STAGE(PG8_SB(1, 0), cB + kstep, voffB); PG8_STAGE(PG8_SA(1, 0), cA + kstep, voffA); PG8_STAGE(PG8_SB(1, 1), cB + hstepB + kstep, voffB);
        PG8_WAIT_V(6); PG8_BAR;
    } else {
        PG8_STAGE(PG8_SB(0, 0), cB, voffB); PG8_STAGE(PG8_SA(0, 0), cA, voffA); PG8_STAGE(PG8_SB(0, 1), cB + hstepB, voffB); PG8_STAGE(PG8_SA(0, 1), cA + hstepA, voffA);
        if (wr == 1) PG8_BAR;
        PG8_WAIT_V(4); PG8_BAR;
        PG8_STAGE(PG8_SB(1, 0), cB + kstep, voffB); PG8_STAGE(PG8_SA(1, 0), cA + kstep, voffA); PG8_STAGE(PG8_SB(1, 1), cB + hstepB + kstep, voffB);
        PG8_WAIT_V(6); PG8_BAR;
    }
    for (;;) {
        const bool has_next = S.next(ui + 1, nxt);
        const char* nA = has_next ? (const char*)g.A + (size_t)nxt.pm * tstepA + (size_t)nxt.kc * ksplit : cA; const char* nB = has_next ? (const char*)g.Bt + (size_t)nxt.pn * tstepB + (size_t)nxt.kc * ksplit + (nxt.pm >= g.bsplit_pm ? (size_t)g.bsplit_off * 2 : (size_t)0) : cB;
        for (int t = 0; t < nt; t += 2) {
            const bool last = (t == nt - 2);
            const char* a1 = cA + (size_t)(t + 1) * kstep;
            const char* a2 = last ? nA : cA + (size_t)(t + 2) * kstep; const char* b2 = last ? nB : cB + (size_t)(t + 2) * kstep;
            const char* a3 = a2 + kstep; const char* b3 = b2 + kstep;
            if (last && has_next) S.a_ready(nxt);
            if constexpr (SP2) {
            PG8_LDB(B0, 0, 0); PG8_LDB(B1, 0, 1); PG8_SCHED; PG8_LDA(At, 0, 0); PG8_STAGE(PG8_SA(1, 1), a1 + hstepA, voffA);
            PG8_WAIT_V(8); PG8_WAIT_L(0); PG8_BAR; PG8_MMA(0, 0, At, B0); PG8_MMA(0, 1, At, B1); PG8_BAR; PG8_SCHED;
            PG8_LDA(At, 0, 1); PG8_STAGE(PG8_SB(0, 0), b2, voffB); PG8_STAGE(PG8_SB(0, 1), b2 + hstepB, voffB); PG8_STAGE(PG8_SA(0, 0), a2, voffA);
            PG8_WAIT_V(8); PG8_WAIT_L(0); PG8_BAR; PG8_MMA(1, 0, At, B0); PG8_MMA(1, 1, At, B1); PG8_BAR; PG8_SCHED;
            PG8_LDB(B0, 1, 0); PG8_LDB(B1, 1, 1); PG8_SCHED; PG8_LDA(At, 1, 0); PG8_STAGE(PG8_SA(0, 1), a2 + hstepA, voffA);
            PG8_WAIT_V(8); PG8_WAIT_L(0); PG8_BAR; PG8_MMA(0, 0, At, B0); PG8_MMA(0, 1, At, B1); PG8_BAR; PG8_SCHED;
            PG8_LDA(At, 1, 1); PG8_STAGE(PG8_SB(1, 0), b3, voffB); PG8_STAGE(PG8_SB(1, 1), b3 + hstepB, voffB); PG8_STAGE(PG8_SA(1, 0), a3, voffA);
            PG8_WAIT_V(8); PG8_WAIT_L(0); PG8_BAR; PG8_MMA(1, 0, At, B0); PG8_MMA(1, 1, At, B1); PG8_BAR; PG8_SCHED;
            } else {
            PG8_LDB(B0, 0, 0); PG8_SCHED; PG8_LDA(At, 0, 0); PG8_STAGE(PG8_SA(1, 1), a1 + hstepA, voffA);
            PG8_WAIT_L(8); PG8_BAR; PG8_WAIT_L(0); PG8_MMA(0, 0, At, B0); PG8_BAR; PG8_SCHED;
            PG8_LDB(B1, 0, 1); PG8_STAGE(PG8_SB(0, 0), b2, voffB);
            PG8_BAR; PG8_WAIT_L(0); PG8_MMA(0, 1, At, B1); PG8_BAR;
            PG8_LDA(At, 0, 1); PG8_STAGE(PG8_SA(0, 0), a2, voffA);
            PG8_BAR; PG8_WAIT_L(0); PG8_MMA(1, 0, At, B0); PG8_BAR; PG8_SCHED;
            PG8_STAGE(PG8_SB(0, 1), b2 + hstepB, voffB);
            PG8_WAIT_V(6); PG8_BAR; PG8_MMA(1, 1, At, B1); PG8_BAR;
            PG8_LDB(B0, 1, 0); PG8_SCHED; PG8_LDA(At, 1, 0); PG8_STAGE(PG8_SA(0, 1), a2 + hstepA, voffA);
            PG8_WAIT_L(8); PG8_BAR; PG8_WAIT_L(0); PG8_MMA(0, 0, At, B0); PG8_BAR; PG8_SCHED;
            PG8_LDB(B1, 1, 1); PG8_STAGE(PG8_SB(1, 0), b3, voffB);
            PG8_BAR; PG8_WAIT_L(0); PG8_MMA(0, 1, At, B1); PG8_BAR;
            PG8_LDA(At, 1, 1); PG8_STAGE(PG8_SA(1, 0), a3, voffA);
            PG8_BAR; PG8_WAIT_L(0); PG8_MMA(1, 0, At, B0); PG8_BAR; PG8_SCHED;
            PG8_STAGE(PG8_SB(1, 1), b3 + hstepB, voffB);
            PG8_WAIT_V(6); PG8_BAR; PG8_MMA(1, 1, At, B1); PG8_BAR;
            }
        }
        if constexpr (ALIGN_EPI) { if (wr == 0) PG8_BAR; }
        if constexpr (!Epi::AFTER_DRAIN) { E(acc, cur, wr, wc, fr, fq); S.done(cur); }
        if (!has_next) break;
#pragma unroll
        for (int a = 0; a < 2; ++a)
#pragma unroll
            for (int b = 0; b < 2; ++b)
#pragma unroll
                for (int m = 0; m < 4; ++m)
#pragma unroll
                    for (int n = 0; n < 2; ++n) acc[a][b][m][n] = (f32x4){0.f, 0.f, 0.f, 0.f};
        cur = nxt; cA = nA; cB = nB; ++ui;
        if constexpr (ALIGN_EPI) { if (wr == 1) PG8_BAR; }
    }
    PG8_WAIT_V(0);
    if constexpr (!ALIGN_EPI) { if (wr == 0) PG8_BAR; }
    PG8_BAR;
    if constexpr (Epi::AFTER_DRAIN) { E.fused(acc, cur, wr, wc, fr, fq, lds, wid, lane); S.done(cur); }
#undef PG8_SA
#undef PG8_SB
#undef PG8_STAGE
#undef PG8_LDA
#undef PG8_LDB
#undef PG8_MMA
#undef PG8_WAIT_V
#undef PG8_WAIT_L
#undef PG8_BAR
#undef PG8_SCHED
}
}
namespace att {
using bf16 = __hip_bfloat16;
constexpr int   D = 128, NW = 8, QBLK = 32, KVBLK = 64;
constexpr float SCALE = 0.088388347648318440f;
constexpr float THR = 8.f;
constexpr float CL2 = SCALE * 1.4426950408889634f;
constexpr float NEGBIG = -3.0e38f;
constexpr int SHM_V = KVBLK * D * 2, SHM_K = KVBLK * D * 2;
constexpr int LDS_WS = 2 * SHM_V + 2 * SHM_K, LDS_TAB = LDS_WS + NW * 64 * 4, TAB_FLOATS = 2048, LDS_ATT_END = LDS_TAB + TAB_FLOATS * 4;
using bf16x8 = __attribute__((ext_vector_type(8))) short;
using s16x4  = __attribute__((ext_vector_type(4))) short;
using f32x16 = __attribute__((ext_vector_type(16))) float;
using f32x8  = __attribute__((ext_vector_type(8))) float;
using u32x4  = __attribute__((ext_vector_type(4))) unsigned;
#define KSWZ(row, colB) ((row) * 256 + ((colB) ^ (((row) & 7) << 4)))
#define SBAR() __builtin_amdgcn_sched_barrier(0)
__device__ __forceinline__ int crow(int r, int hi) { return (r & 3) + 8 * (r >> 2) + 4 * hi; }
__device__ __forceinline__ unsigned cvtpk(float lo, float hi) {
  unsigned r; asm volatile("v_cvt_pk_bf16_f32 %0, %1, %2" : "=v"(r) : "v"(lo), "v"(hi)); return r;
}
template <typename TIn> struct Stage;
template <> struct Stage<bf16>  { using T = bf16x8;
  __device__ static __forceinline__ T ld8(const bf16* p) { return *reinterpret_cast<const bf16x8*>(p); }
  __device__ static __forceinline__ bf16x8 tobf(T x) { return x; } };
template <> struct Stage<float> { using T = f32x8;
  __device__ static __forceinline__ T ld8(const float* p) { return *reinterpret_cast<const f32x8*>(p); }
  __device__ static __forceinline__ bf16x8 tobf(T x) {
    u32x4 w = {cvtpk(x[0], x[1]), cvtpk(x[2], x[3]), cvtpk(x[4], x[5]), cvtpk(x[6], x[7])}; return *reinterpret_cast<bf16x8*>(&w); } };

__device__ __forceinline__ void partialSM(f32x16& p0, f32x16& p1, float& m_reg, float& mn, float& alpha) {
  constexpr float C = SCALE * 1.4426950408889634f;
  float pmax = p0[0]; for (int r = 1; r < 16; ++r) pmax = fmaxf(pmax, p0[r]); for (int r = 0; r < 16; ++r) pmax = fmaxf(pmax, p1[r]);
  { auto rr = __builtin_amdgcn_permlane32_swap(__float_as_uint(pmax), __float_as_uint(pmax), false, false);
    pmax = fmaxf(__uint_as_float(rr[0]), __uint_as_float(rr[1])); }
  if (__builtin_expect(__all(pmax - m_reg <= THR / SCALE), 1)) { mn = m_reg; alpha = 1.f; }
  else { mn = fmaxf(m_reg, pmax); alpha = __builtin_amdgcn_exp2f((m_reg - mn) * C); m_reg = mn; }
  float mnC = -mn * C;
  for (int r = 0; r < 16; ++r) p0[r] = fmaf(p0[r], C, mnC); for (int r = 0; r < 16; ++r) p1[r] = fmaf(p1[r], C, mnC);
  for (int r = 0; r < 16; ++r) p0[r] = __builtin_amdgcn_exp2f(p0[r]);
}
__device__ __forceinline__ void partialSM0(f32x16& p0, f32x16& p1, float& m_reg, float& alpha, const bool first) {
  constexpr float THR2 = THR * 1.4426950408889634f;
  float pmax = p0[0]; for (int r = 1; r < 16; ++r) pmax = fmaxf(pmax, p0[r]); for (int r = 0; r < 16; ++r) pmax = fmaxf(pmax, p1[r]);
  { auto rr = __builtin_amdgcn_permlane32_swap(__float_as_uint(pmax), __float_as_uint(pmax), false, false);
    pmax = fmaxf(__uint_as_float(rr[0]), __uint_as_float(rr[1])); }
  if (!first && __builtin_expect(__all(pmax <= THR2), 1)) { alpha = 1.f; }
  else { const float dl = first ? pmax : fmaxf(pmax, 0.f); m_reg += dl; alpha = first ? 1.f : __builtin_amdgcn_exp2f(-dl);
    for (int r = 0; r < 16; ++r) { p0[r] -= dl; p1[r] -= dl; } }
  for (int r = 0; r < 16; ++r) p0[r] = __builtin_amdgcn_exp2f(p0[r]);
}
__device__ __forceinline__ void finishSM(f32x16& p0, f32x16& p1, float alpha, float& l_reg, bf16x8& pa0, bf16x8& pa1, bf16x8& pa2, bf16x8& pa3) {
  for (int r = 0; r < 16; ++r) p1[r] = __builtin_amdgcn_exp2f(p1[r]);
  float ps = 0; for (int r = 0; r < 16; ++r) ps += p0[r]; for (int r = 0; r < 16; ++r) ps += p1[r];
  { auto rr = __builtin_amdgcn_permlane32_swap(__float_as_uint(ps), __float_as_uint(ps), false, false);
    ps = __uint_as_float(rr[0]) + __uint_as_float(rr[1]); }
  l_reg = l_reg * alpha + ps;
#define PK4(P, BASE, OUT) do { unsigned a0 = cvtpk(P[BASE + 0], P[BASE + 1]), a1 = cvtpk(P[BASE + 2], P[BASE + 3]);   \
    unsigned b0 = cvtpk(P[BASE + 4], P[BASE + 5]), b1 = cvtpk(P[BASE + 6], P[BASE + 7]);                              \
    auto r0 = __builtin_amdgcn_permlane32_swap(a0, b0, false, false); auto r1 = __builtin_amdgcn_permlane32_swap(a1, b1, false, false); \
    u32x4 w = {r0[0], r1[0], r0[1], r1[1]}; OUT = *reinterpret_cast<bf16x8*>(&w); } while (0)
  PK4(p0, 0, pa0); PK4(p0, 8, pa1); PK4(p1, 0, pa2); PK4(p1, 8, pa3);
#undef PK4
}
__device__ __forceinline__ void qkt(f32x16& p0, f32x16& p1, const bf16* Ks, const bf16x8* qr, int r32, int hi) {
  for (int d0 = 0; d0 < 8; ++d0) { int cb = (d0 * 16 + hi * 8) * 2;
    bf16x8 b0 = *reinterpret_cast<const bf16x8*>((const char*)Ks + KSWZ(r32, cb));
    bf16x8 b1 = *reinterpret_cast<const bf16x8*>((const char*)Ks + KSWZ(32 + r32, cb));
    p0 = __builtin_amdgcn_mfma_f32_32x32x16_bf16(b0, qr[d0], p0, 0, 0, 0);
    p1 = __builtin_amdgcn_mfma_f32_32x32x16_bf16(b1, qr[d0], p1, 0, 0, 0); }
}
__device__ __forceinline__ int v_st(int k, int c) { const int kk = (k & ~0xC) | ((k & 4) << 1) | ((k & 8) >> 1); return ((kk >> 3) * 4 + (c >> 5)) * 512 + ((kk & 7) * 32 + (c & 31)) * 2; }
__device__ __forceinline__ int v_rd_base(int lane) { return ((lane & 3) << 3) | (((lane >> 2) & 3) << 6) | (((lane >> 4) & 1) << 5) | (((lane >> 5) & 1) << 8); }
constexpr int v_rd_off(int d0, int ks, int half) { return d0 * 512 + ks * 4096 + half * 2048; }
template <int OFF> __device__ __forceinline__ s16x4 tr_read(int vb) {
  s16x4 r; asm volatile("ds_read_b64_tr_b16 %0, %1 offset:%2" : "=&v"(r) : "v"(vb), "i"(OFF) : "memory"); return r;
}
template <int D0> __device__ __forceinline__ void pv_one(f32x16& od, int vb, bf16x8 pa0, bf16x8 pa1, bf16x8 pa2, bf16x8 pa3) {
  const s16x4 l0 = tr_read<v_rd_off(D0, 0, 0)>(vb), h0 = tr_read<v_rd_off(D0, 0, 1)>(vb), l1 = tr_read<v_rd_off(D0, 1, 0)>(vb), h1 = tr_read<v_rd_off(D0, 1, 1)>(vb);
  const s16x4 l2 = tr_read<v_rd_off(D0, 2, 0)>(vb), h2 = tr_read<v_rd_off(D0, 2, 1)>(vb), l3 = tr_read<v_rd_off(D0, 3, 0)>(vb), h3 = tr_read<v_rd_off(D0, 3, 1)>(vb);
  asm volatile("s_waitcnt lgkmcnt(0)" ::: "memory"); SBAR();
#define PK(L, H) (bf16x8){L[0], L[1], L[2], L[3], H[0], H[1], H[2], H[3]}
  od = __builtin_amdgcn_mfma_f32_32x32x16_bf16(pa0, PK(l0, h0), od, 0, 0, 0);
  od = __builtin_amdgcn_mfma_f32_32x32x16_bf16(pa1, PK(l1, h1), od, 0, 0, 0);
  od = __builtin_amdgcn_mfma_f32_32x32x16_bf16(pa2, PK(l2, h2), od, 0, 0, 0);
  od = __builtin_amdgcn_mfma_f32_32x32x16_bf16(pa3, PK(l3, h3), od, 0, 0, 0);
#undef PK
}
__device__ __forceinline__ void pv_d0(f32x16* o, int vb, bf16x8 pa0, bf16x8 pa1, bf16x8 pa2, bf16x8 pa3) {
  pv_one<0>(o[0], vb, pa0, pa1, pa2, pa3); pv_one<1>(o[1], vb, pa0, pa1, pa2, pa3); pv_one<2>(o[2], vb, pa0, pa1, pa2, pa3); pv_one<3>(o[3], vb, pa0, pa1, pa2, pa3);
}
template <int KS> __device__ __forceinline__ void pv_ks(f32x16* o, int vb, bf16x8 pa) {
  const s16x4 l0 = tr_read<v_rd_off(0, KS, 0)>(vb), h0 = tr_read<v_rd_off(0, KS, 1)>(vb), l1 = tr_read<v_rd_off(1, KS, 0)>(vb), h1 = tr_read<v_rd_off(1, KS, 1)>(vb);
  const s16x4 l2 = tr_read<v_rd_off(2, KS, 0)>(vb), h2 = tr_read<v_rd_off(2, KS, 1)>(vb), l3 = tr_read<v_rd_off(3, KS, 0)>(vb), h3 = tr_read<v_rd_off(3, KS, 1)>(vb);
  asm volatile("s_waitcnt lgkmcnt(0)" ::: "memory"); SBAR();
#define PK(L, H) (bf16x8){L[0], L[1], L[2], L[3], H[0], H[1], H[2], H[3]}
  o[0] = __builtin_amdgcn_mfma_f32_32x32x16_bf16(pa, PK(l0, h0), o[0], 0, 0, 0);
  o[1] = __builtin_amdgcn_mfma_f32_32x32x16_bf16(pa, PK(l1, h1), o[1], 0, 0, 0);
  o[2] = __builtin_amdgcn_mfma_f32_32x32x16_bf16(pa, PK(l2, h2), o[2], 0, 0, 0);
  o[3] = __builtin_amdgcn_mfma_f32_32x32x16_bf16(pa, PK(l3, h3), o[3], 0, 0, 0);
#undef PK
}

__device__ __forceinline__ int t5_bucket(int rel) {
  const int base = rel > 0 ? 16 : 0; const int n = rel < 0 ? -rel : rel;
  const int v = n < 8 ? n : (n < 15 ? 8 : (n < 27 ? 9 : (n < 50 ? 10 : (n < 91 ? 11 : (n < 166 ? 12 : (n < 305 ? 13 : (n < 559 ? 14 : 15)))))));
  return base + v;
}

template <int MODE>
__device__ __forceinline__ void attn_core(const bf16* __restrict__ Qw, const bf16* __restrict__ Kh, const bf16* __restrict__ Vh, const long ldk,
                                          const int kbeg, const int NT, const int L, const int qrow, const int qw0,
                                          const float* tab, const int taboff, const float cL, const float cR,
                                          char* lds, f32x16 (&o)[4], float& l_out, float& m_out) {
  using St = Stage<bf16>;
  int tid_ = threadIdx.x; asm volatile("" : "+v"(tid_));
  const int tid = tid_, wid = __builtin_amdgcn_readfirstlane(tid >> 6), lane = tid & 63, r32 = lane & 31, hi = lane >> 5;
  bf16* V_lds = (bf16*)lds; bf16* K_lds = (bf16*)(lds + 2 * SHM_V);
  float* ws = (float*)(lds + LDS_WS) + wid * 64; float* al_l = ws + 32;
  float m_reg = (MODE == 0) ? 0.f : -1e30f, l_reg = 0; bf16x8 qr[8];
#pragma unroll
  for (int d = 0; d < 4; ++d) o[d] = f32x16{};
#pragma unroll
  for (int d0 = 0; d0 < 8; ++d0) qr[d0] = St::ld8(Qw + d0 * 16);
  const int sr = tid >> 4, sc = (tid & 15) * 8, vst0 = v_st(sr, sc), vst1 = v_st(32 + sr, sc);
  const int vb0 = (int)(uintptr_t)V_lds + v_rd_base(lane);
  struct { typename St::T vs0, vs1, ks0, ks1; } sr_[2];
#define CLAMPR(x) ((x) < 0 ? 0 : ((x) > L - 1 ? L - 1 : (x)))
#define SLOAD(i, j) do { const int k0_ = kbeg + (j) * KVBLK; const long ra_ = (long)CLAMPR(k0_ + sr) * ldk + sc, rb_ = (long)CLAMPR(k0_ + 32 + sr) * ldk + sc; \
    sr_[i].vs0 = St::ld8(Vh + ra_); sr_[i].vs1 = St::ld8(Vh + rb_); sr_[i].ks0 = St::ld8(Kh + ra_); sr_[i].ks1 = St::ld8(Kh + rb_); } while (0)
#define SWRITE(b, i) do { *(bf16x8*)((char*)V_lds + (b) * SHM_V + vst0) = St::tobf(sr_[i].vs0);          \
    *(bf16x8*)((char*)V_lds + (b) * SHM_V + vst1) = St::tobf(sr_[i].vs1); int kc = sc * 2;               \
    *(bf16x8*)((char*)K_lds + (b) * SHM_K + KSWZ(sr, kc)) = St::tobf(sr_[i].ks0);                       \
    *(bf16x8*)((char*)K_lds + (b) * SHM_K + KSWZ(32 + sr, kc)) = St::tobf(sr_[i].ks1); } while (0)
#define SWAIT() asm volatile("s_waitcnt vmcnt(4)" ::: "memory")
#define RESC(a) do { if (__any((a) < 1.f)) { if (hi == 0) al_l[r32] = (a); asm volatile("s_waitcnt lgkmcnt(0)" ::: "memory"); \
    for (int d = 0; d < 4; ++d) for (int r = 0; r < 16; ++r) o[d][r] *= al_l[crow(r, hi)]; } } while (0)
#define FILLP(P0, P1, v) do { _Pragma("unroll") for (int r = 0; r < 16; ++r) { P0[r] = (v); P1[r] = (v); } } while (0)
#define LOOKP(P0, P1, k0_) do { const float* tp_ = tab + ((k0_) - qrow + taboff + 4 * hi); \
    _Pragma("unroll") for (int r = 0; r < 16; ++r) { P0[r] = tp_[(r & 3) + 8 * (r >> 2)]; P1[r] = tp_[32 + (r & 3) + 8 * (r >> 2)]; } } while (0)
#ifdef EXP_SIMPLEINIT
#define INIT0(P0, P1, k0_) FILLP(P0, P1, cL)
#else
#define INIT0(P0, P1, k0_) do { if (k0_ + 63 - qw0 <= -559 || k0_ - qw0 - 31 >= 559) { const float cc_ = ((k0_ < qw0) ? cL : cR) - m_reg; FILLP(P0, P1, cc_); } \
    else { LOOKP(P0, P1, k0_); _Pragma("unroll") for (int r = 0; r < 16; ++r) { P0[r] -= m_reg; P1[r] -= m_reg; } } } while (0)
#endif
#define PSM(P0, P1, mn_, al_, first_) do { if (MODE == 0) partialSM0(P0, P1, m_reg, al_, first_); else partialSM(P0, P1, m_reg, mn_, al_); } while (0)
#define INITP(P0, P1, j) do { const int k0_ = kbeg + (j) * KVBLK; \
    if (MODE == 0) { INIT0(P0, P1, k0_); } \
    else { if (k0_ < 0 || k0_ >= L || k0_ - qw0 - 31 > 64 || k0_ + 63 - qw0 < -64) { FILLP(P0, P1, NEGBIG); live_ = false; } else LOOKP(P0, P1, k0_); } } while (0)
  f32x16 pA0, pA1, pB0, pB1; float mnA, mnB, alA, alB; bf16x8 pa0, pa1, pa2, pa3;
  constexpr int SE = 0, SO = 1;
  SLOAD(SE, 0); asm volatile("s_waitcnt vmcnt(0)" ::: "memory"); SWRITE(0, SE); __syncthreads();
  bool live_ = true; INITP(pA0, pA1, 0); qkt(pA0, pA1, K_lds, qr, r32, hi); PSM(pA0, pA1, mnA, alA, true);
  SLOAD(SO, 1); if (2 < NT) SLOAD(SE, 2);
  SWAIT(); SWRITE(1, SO); __syncthreads();
  for (int j = 1; j + 1 < NT; j += 2) {
    SBAR(); live_ = true; INITP(pB0, pB1, j);
    SBAR(); qkt(pB0, pB1, (bf16*)((char*)K_lds + SHM_K), qr, r32, hi);
    finishSM(pA0, pA1, alA, l_reg, pa0, pa1, pa2, pa3); SBAR();
    SLOAD(SO, j + 2); SBAR();
    pv_d0(o, vb0, pa0, pa1, pa2, pa3); PSM(pB0, pB1, mnB, alB, false);
    __syncthreads(); SWAIT(); SWRITE(0, SE);
    RESC(alB); __syncthreads();
    SBAR(); live_ = true; INITP(pA0, pA1, j + 1);
    SBAR(); qkt(pA0, pA1, K_lds, qr, r32, hi);
    finishSM(pB0, pB1, alB, l_reg, pa0, pa1, pa2, pa3); SBAR();
    if (j + 3 < NT) SLOAD(SE, j + 3); SBAR();
    pv_d0(o, vb0 + (int)SHM_V, pa0, pa1, pa2, pa3); PSM(pA0, pA1, mnA, alA, false);
    __syncthreads(); SWAIT(); SWRITE(1, SO);
    RESC(alA); __syncthreads();
  }
  SBAR(); live_ = true; INITP(pB0, pB1, NT - 1);
  SBAR(); qkt(pB0, pB1, (bf16*)((char*)K_lds + SHM_K), qr, r32, hi);
  finishSM(pA0, pA1, alA, l_reg, pa0, pa1, pa2, pa3); SBAR();
  pv_d0(o, vb0, pa0, pa1, pa2, pa3); PSM(pB0, pB1, mnB, alB, false);
  __syncthreads(); RESC(alB);
  finishSM(pB0, pB1, alB, l_reg, pa0, pa1, pa2, pa3); SBAR();
  pv_d0(o, vb0 + (int)SHM_V, pa0, pa1, pa2, pa3);
  l_out = l_reg; m_out = m_reg;
#undef CLAMPR
#undef SLOAD
#undef SWRITE
#undef SWAIT
#undef RESC
#undef FILLP
#undef LOOKP
#undef INITP
#undef PSM
#undef INIT0
}
}
namespace att3 {
using namespace att;
constexpr int VBUF = 32768, KBUF = 16384;
constexpr int L_V = 0, L_K = 2 * VBUF, L_XM = L_K + 2 * KBUF, L_XP = L_XM + 2048, L_WS = L_XP + 32768, L_TAB = L_WS + 2048, L_END = L_TAB + 8192;
__device__ __forceinline__ void attn_core3(const bf16* __restrict__ Qw, const bf16* __restrict__ Kh, const bf16* __restrict__ Vh, const long ldk, const int NT,
                                           const int qrow, const int qw0, const float* tab, const float cL, const float cR, char* lds, f32x16 (&o)[4], float& l_out) {
  using St = Stage<bf16>;
  constexpr float THR2 = THR * 1.4426950408889634f;
  int tid_ = threadIdx.x; asm volatile("" : "+v"(tid_));
  const int tid = tid_, wid = __builtin_amdgcn_readfirstlane(tid >> 6), lane = tid & 63, r32 = lane & 31, hi = lane >> 5, vh = wid & 1;
  char* V_lds = lds + L_V; char* K_lds = lds + L_K;
  float* xm = (float*)(lds + L_XM); char* xp = lds + L_XP;
  float* al_l = (float*)(lds + L_WS) + wid * 64;
  float m_reg = 0.f, l_reg = 0.f, pm_own; bf16x8 qr[8];
#pragma unroll
  for (int d = 0; d < 4; ++d) o[d] = f32x16{};
#pragma unroll
  for (int d0 = 0; d0 < 8; ++d0) qr[d0] = St::ld8(Qw + d0 * 16);
  const int vb0 = (int)(uintptr_t)V_lds + vh * 16384 + v_rd_base(lane);
  typedef __attribute__((address_space(3))) unsigned lds_u32; typedef __attribute__((address_space(3))) char lds_c;
  lds_c* const kdst = (lds_c*)K_lds + wid * 1024; lds_c* const vdst = (lds_c*)V_lds + wid * 1024;
  const int r8_ = (lane >> 2) & 7;
  const unsigned lk_off = (unsigned)(((lane >> 4) * (int)ldk + (((lane & 15) ^ ((wid * 4 + (lane >> 4)) & 7)) * 8)) * 2);
  const unsigned lv_off = (unsigned)((((r8_ & 3) + 8 * (r8_ >> 2)) * (int)ldk + 32 * (lane >> 5) + 8 * (lane & 3)) * 2);
#define DMA_K(t, kbuf) do { _Pragma("unroll") for (int i = 0; i < 2; ++i) { const char* sb_ = (const char*)Kh + ((long)((t) * KVBLK + wid * 4 + 32 * i) * ldk) * 2; \
      __builtin_amdgcn_global_load_lds((const unsigned*)(sb_ + lk_off), (lds_u32*)(kdst + (kbuf) * KBUF + i * 8192), 16, 0, 0); } } while (0)
#define DMA_V(t, vbuf) do { _Pragma("unroll") for (int i = 0; i < 4; ++i) { const int S_ = (wid >> 1) + 4 * (i & 1); \
      const char* sb_ = (const char*)Vh + ((long)((t) * KVBLK + 16 * (S_ >> 1) + 4 * (S_ & 1)) * ldk + (i >> 1) * 128 + 64 * (wid & 1)) * 2; \
      __builtin_amdgcn_global_load_lds((const unsigned*)(sb_ + lv_off), (lds_u32*)(vdst + (vbuf) * VBUF + i * 8192), 16, 0, 0); } } while (0)
#define WAITBAR() asm volatile("s_waitcnt vmcnt(0) lgkmcnt(0)\n\ts_barrier" ::: "memory")
#define INIT3(P, t) do { const int k0_ = (t) * KVBLK + 32 * vh; \
    if (k0_ + 31 - qw0 <= -559 || k0_ - qw0 - 31 >= 559) { const float cc_ = ((k0_ < qw0) ? cL : cR) - m_reg; _Pragma("unroll") for (int r = 0; r < 16; ++r) P[r] = cc_; } \
    else { const float* tp_ = tab + (k0_ - qrow + 1024 + 4 * hi); _Pragma("unroll") for (int r = 0; r < 16; ++r) P[r] = tp_[(r & 3) + 8 * (r >> 2)] - m_reg; } } while (0)
#define ROWMAX3(P, xbuf) do { float pmx = P[0]; _Pragma("unroll") for (int r = 1; r < 16; ++r) pmx = fmaxf(pmx, P[r]); \
    auto rr = __builtin_amdgcn_permlane32_swap(__float_as_uint(pmx), __float_as_uint(pmx), false, false); pm_own = fmaxf(__uint_as_float(rr[0]), __uint_as_float(rr[1])); \
    if (hi == 0) xm[(xbuf) * 256 + wid * 32 + r32] = pm_own; } while (0)
#define PACK3(P, B, OUT) do { unsigned a0 = cvtpk(P[B + 0], P[B + 1]), a1 = cvtpk(P[B + 2], P[B + 3]), b0 = cvtpk(P[B + 4], P[B + 5]), b1 = cvtpk(P[B + 6], P[B + 7]); \
    auto r0 = __builtin_amdgcn_permlane32_swap(a0, b0, false, false); auto r1 = __builtin_amdgcn_permlane32_swap(a1, b1, false, false); \
    u32x4 w = {r0[0], r1[0], r0[1], r1[1]}; OUT = *reinterpret_cast<bf16x8*>(&w); } while (0)
#define STAGE3(j, PC, PN, EV, FIRST_, LAST_) do { \
    if (!(LAST_) && (j) + 2 < NT) DMA_K((j) + 2, (EV) ? 0 : 1); \
    DMA_V((j), (EV) ? 0 : 1); \
    bf16x8 qX, qY; if (!(FIRST_)) { qX = *(const bf16x8*)(xp + ((EV) ? 1 : 0) * 16384 + (wid ^ 1) * 2048 + lane * 32); qY = *(const bf16x8*)(xp + ((EV) ? 1 : 0) * 16384 + (wid ^ 1) * 2048 + lane * 32 + 16); } \
    const float pmx_ = fmaxf(pm_own, xm[((EV) ? 0 : 1) * 256 + (wid ^ 1) * 32 + r32]); float alpha = 1.f; \
    if (FIRST_) { m_reg = pmx_; _Pragma("unroll") for (int r = 0; r < 16; ++r) PC[r] -= pmx_; } \
    else if (!__builtin_expect(__all(pmx_ <= THR2), 1)) { const float dl = fmaxf(pmx_, 0.f); m_reg += dl; alpha = __builtin_amdgcn_exp2f(-dl); _Pragma("unroll") for (int r = 0; r < 16; ++r) PC[r] -= dl; } \
    if (!(LAST_)) { INIT3(PN, (j) + 1); \
      const char* kb_ = K_lds + ((EV) ? 1 : 0) * KBUF; \
      _Pragma("unroll") for (int d0 = 0; d0 < 8; ++d0) { const int cb = (d0 * 16 + hi * 8) * 2; \
        const bf16x8 bk = *reinterpret_cast<const bf16x8*>(kb_ + KSWZ(32 * vh + r32, cb)); PN = __builtin_amdgcn_mfma_f32_32x32x16_bf16(bk, qr[d0], PN, 0, 0, 0); \
        PC[2 * d0] = __builtin_amdgcn_exp2f(PC[2 * d0]); PC[2 * d0 + 1] = __builtin_amdgcn_exp2f(PC[2 * d0 + 1]); } } \
    else { _Pragma("unroll") for (int r = 0; r < 16; ++r) PC[r] = __builtin_amdgcn_exp2f(PC[r]); } \
    { bf16x8 a0_, a1_, a2_, a3_; const int vbb_ = vb0 + ((EV) ? 1 : 0) * VBUF; \
      if (!(FIRST_)) { a0_ = vh ? qX : paX; a1_ = vh ? qY : paY; a2_ = vh ? paX : qX; a3_ = vh ? paY : qY; pv_ks<0>(o, vbb_, a0_); } \
      if (!(LAST_)) ROWMAX3(PN, (EV) ? 1 : 0); \
      if (!(FIRST_)) pv_ks<1>(o, vbb_, a1_); \
      { float ps = 0.f; _Pragma("unroll") for (int r = 0; r < 16; ++r) ps += PC[r]; \
        auto rr = __builtin_amdgcn_permlane32_swap(__float_as_uint(ps), __float_as_uint(ps), false, false); ps = __uint_as_float(rr[0]) + __uint_as_float(rr[1]); l_reg = l_reg * alpha + ps; } \
      if (!(FIRST_)) pv_ks<2>(o, vbb_, a2_); \
      PACK3(PC, 0, paX); \
      if (!(FIRST_)) pv_ks<3>(o, vbb_, a3_); \
      PACK3(PC, 8, paY); \
      *(bf16x8*)(xp + ((EV) ? 0 : 1) * 16384 + wid * 2048 + lane * 32) = paX; *(bf16x8*)(xp + ((EV) ? 0 : 1) * 16384 + wid * 2048 + lane * 32 + 16) = paY; } \
    if (__any(alpha < 1.f)) { if (hi == 0) al_l[r32] = alpha; asm volatile("s_waitcnt lgkmcnt(0)" ::: "memory"); \
      _Pragma("unroll") for (int d = 0; d < 4; ++d) _Pragma("unroll") for (int r = 0; r < 16; ++r) o[d][r] *= al_l[crow(r, hi)]; } \
    WAITBAR(); \
  } while (0)
  f32x16 pA, pB; bf16x8 paX, paY;
  DMA_K(0, 0); DMA_K(1, 1); WAITBAR();
  INIT3(pA, 0);
  { const char* kb_ = K_lds;
#pragma unroll
    for (int d0 = 0; d0 < 8; ++d0) { const int cb = (d0 * 16 + hi * 8) * 2; const bf16x8 bk = *reinterpret_cast<const bf16x8*>(kb_ + KSWZ(32 * vh + r32, cb)); pA = __builtin_amdgcn_mfma_f32_32x32x16_bf16(bk, qr[d0], pA, 0, 0, 0); } }
  ROWMAX3(pA, 0);
  WAITBAR();
  STAGE3(0, pA, pB, true, true, false);
#pragma unroll 1
  for (int j = 1; j < NT - 1; j += 2) {
    STAGE3(j, pB, pA, false, false, false);
    STAGE3(j + 1, pA, pB, true, false, false);
  }
  STAGE3(NT - 1, pB, pA, false, false, true);
  { const bf16x8 qX = *(const bf16x8*)(xp + 16384 + (wid ^ 1) * 2048 + lane * 32), qY = *(const bf16x8*)(xp + 16384 + (wid ^ 1) * 2048 + lane * 32 + 16);
    const bf16x8 a0_ = vh ? qX : paX, a1_ = vh ? qY : paY, a2_ = vh ? paX : qX, a3_ = vh ? paY : qY; pv_d0(o, vb0 + VBUF, a0_, a1_, a2_, a3_); }
  asm volatile("s_waitcnt lgkmcnt(0)\n\ts_barrier" ::: "memory");
  l_out = l_reg;
#undef DMA_K
#undef DMA_V
#undef WAITBAR
#undef INIT3
#undef ROWMAX3
#undef PACK3
#undef STAGE3
}
}

constexpr int SEQ = 8192, DM = 2048, DFF = 8192, NLAYER = 4;
constexpr int EV_QKV = 4608, EV_N = 5632  , OD_N = 6144;
constexpr float NORM_EPS = 1e-6f;
constexpr size_t MiB = 1u << 20;
constexpr size_t WS_WIN_E = 0;
constexpr size_t WS_WOUT = 44 * MiB;
constexpr size_t WS_WQKV_O = 76 * MiB;
constexpr size_t WS_WFF1 = 124 * MiB;
constexpr size_t WS_WFF2 = 252 * MiB;
constexpr size_t WS_DFT = 380 * MiB;
constexpr size_t WS_HPM = 508 * MiB;
constexpr size_t WS_H = 636 * MiB;
constexpr size_t WS_CAT = 668 * MiB;
constexpr size_t WS_WCS = 700 * MiB;
constexpr size_t WS_R = 701 * MiB;
constexpr size_t WS_HID = WS_R;
constexpr size_t WS_PROJ = WS_R;
constexpr size_t WS_YT = WS_R + 72 * MiB;
constexpr size_t WS_T = WS_R + 96 * MiB;
constexpr size_t WS_OB = WS_R + 88 * MiB;
constexpr size_t WS_LSE = WS_R + 160 * MiB;
constexpr size_t WS_PART = WS_R + 162 * MiB;
constexpr size_t WS_END = WS_R + 226 * MiB;
constexpr size_t WS_CTL = WS_END;
constexpr size_t WS_DTAB = WS_END + 16384;
constexpr size_t WS_TOTAL = WS_END + 1 * MiB;
constexpr int LDS_BYTES = 147456;
constexpr int XB_LDS_OFF = 147392;

typedef unsigned short bf16r;
typedef unsigned v4u __attribute__((ext_vector_type(4)));
typedef unsigned v2u __attribute__((ext_vector_type(2)));
typedef float f32x4 __attribute__((ext_vector_type(4)));
#define LAS __attribute__((address_space(3)))
__device__ __forceinline__ unsigned f2bf(float f) { unsigned u = __builtin_bit_cast(unsigned, f); return (u + 0x7fffu + ((u >> 16) & 1u)) >> 16; }
__device__ __forceinline__ unsigned pk2(float lo, float hi) { return f2bf(lo) | (f2bf(hi) << 16); }
__device__ __forceinline__ float bf2f(unsigned short b) { return __builtin_bit_cast(float, (unsigned)b << 16); }
__device__ __forceinline__ float wave_sum(float v) {
#pragma unroll
    for (int o = 1; o < 64; o <<= 1) v += __shfl_xor(v, o);
    return v;
}

struct Args { const float* in[17]; float* out; unsigned char* ws; };

struct TJob { int in_idx; int K; int ldw; int ncols; long src_off; long dst_off; int items_end; int qcols; };
#define TJ_ITEMS(K, nc) (((K) / 64) * ((nc) / 32))
__device__ const TJob g_jobs[18] = {
    {5, 2048, 5120, 4608, 0L,                   (long)(WS_WIN_E),              4608, 0},
    {5, 2048, 5120, 4608, 2048L * 5120,         (long)(WS_WIN_E + 22 * MiB),   9216, 0},
    {7, 2048, 2048, 2048, 0L,                   (long)(WS_WOUT),               11264, 0},
    {14, 2048, 2048, 2048, 0L,                  (long)(WS_WOUT + 8 * MiB),     13312, 0},
    {7, 2048, 2048, 2048, 2048L * 2048,         (long)(WS_WOUT + 16 * MiB),    15360, 0},
    {14, 2048, 2048, 2048, 2048L * 2048,        (long)(WS_WOUT + 24 * MiB),    17408, 0},
    {8, 2048, 6144, 6144, 0L,                   (long)(WS_WQKV_O),             23552, 2048},
    {8, 2048, 6144, 6144, 2048L * 6144,         (long)(WS_WQKV_O + 24 * MiB),  29696, 2048},
    {15, 2048, 8192, 8192, 0L,                  (long)(WS_WFF1),               37888, 0},
    {15, 2048, 8192, 8192, 1L * 2048 * 8192,    (long)(WS_WFF1 + 32 * MiB),    46080, 0},
    {15, 2048, 8192, 8192, 2L * 2048 * 8192,    (long)(WS_WFF1 + 64 * MiB),    54272, 0},
    {15, 2048, 8192, 8192, 3L * 2048 * 8192,    (long)(WS_WFF1 + 96 * MiB),    62464, 0},
    {16, 8192, 2048, 2048, 0L,                  (long)(WS_WFF2),               70656, 0},
    {16, 8192, 2048, 2048, 1L * 2048 * 8192,    (long)(WS_WFF2 + 32 * MiB),    78848, 0},
    {16, 8192, 2048, 2048, 2L * 2048 * 8192,    (long)(WS_WFF2 + 64 * MiB),    87040, 0},
    {16, 8192, 2048, 2048, 3L * 2048 * 8192,    (long)(WS_WFF2 + 96 * MiB),    95232, 0},
    {0, 0, 0, 0, 0L, 0L, 95232, 0}, {0, 0, 0, 0, 0L, 0L, 95232, 0}};
constexpr int TJ_TOTAL = 95232, TJ_NJOBS = 16;

__device__ __forceinline__ void transpose_item(const float* W, int ldw, int K, int ncols, bf16r* WT, LAS float* scr, int item, int lane, int qcols) {
    const int nblk = ncols / 32, kb = item / nblk, nb = item % nblk, k0 = 64 * kb, n0 = 32 * nb;
    float tv[32];
#pragma unroll
    for (int i = 0; i < 32; ++i) { const int kk = 2 * i + (lane >> 5); tv[i] = W[(size_t)(k0 + kk) * ldw + n0 + (lane & 31)]; }
    const float wsc = (n0 < qcols) ? att::CL2 : 1.f;
#pragma unroll
    for (int i = 0; i < 32; ++i) { const int kk = 2 * i + (lane >> 5); scr[kk * 33 + (lane & 31)] = tv[i] * wsc; }
    asm volatile("s_waitcnt lgkmcnt(0)" ::: "memory");
    const int c = lane & 7;
#pragma unroll
    for (int j = 0; j < 4; ++j) { const int n = (lane >> 3) + 8 * j; const LAS float* s = scr + (8 * c) * 33 + n;
        v4u o; o.x = pk2(s[0 * 33], s[1 * 33]); o.y = pk2(s[2 * 33], s[3 * 33]); o.z = pk2(s[4 * 33], s[5 * 33]); o.w = pk2(s[6 * 33], s[7 * 33]);
        *(v4u*)(WT + (size_t)(n0 + n) * K + k0 + 8 * c) = o; }
    asm volatile("s_waitcnt lgkmcnt(0)" ::: "memory");
}

template <bool OUTF32>
__device__ __forceinline__ void rms_row(const float* xrow, const float* g, void* orow, int lane) {
    const f32x4* xr = (const f32x4*)xrow + lane; const f32x4* gr = (const f32x4*)g + lane;
    f32x4 v[8]; float s = 0.f;
#pragma unroll
    for (int j = 0; j < 8; ++j) { v[j] = xr[64 * j]; s += (v[j].x * v[j].x + v[j].y * v[j].y) + (v[j].z * v[j].z + v[j].w * v[j].w); }
    const float rstd = 1.f / sqrtf(wave_sum(s) * (1.f / DM) + NORM_EPS);
#pragma unroll
    for (int j = 0; j < 8; ++j) { const f32x4 gg = gr[64 * j]; const f32x4 y = v[j] * rstd * gg;
        if (OUTF32) ((f32x4*)orow)[lane + 64 * j] = y;
        else { v2u w; w.x = pk2(y.x, y.y); w.y = pk2(y.z, y.w); ((v2u*)orow)[lane + 64 * j] = w; } }
}
__device__ __forceinline__ void rms_pair_row(const float* x, const float* g, bf16r* Hh, bf16r* HPM, int t, int lane) {
    const f32x4* xa = (const f32x4*)(x + (size_t)t * DM) + lane; const f32x4* xb = (const f32x4*)(x + (size_t)(t + 4096) * DM) + lane; const f32x4* gr = (const f32x4*)g + lane;
    f32x4 a[8], b[8]; float sa = 0.f, sb = 0.f;
#pragma unroll
    for (int j = 0; j < 8; ++j) { a[j] = xa[64 * j]; b[j] = xb[64 * j]; sa += (a[j].x * a[j].x + a[j].y * a[j].y) + (a[j].z * a[j].z + a[j].w * a[j].w); sb += (b[j].x * b[j].x + b[j].y * b[j].y) + (b[j].z * b[j].z + b[j].w * b[j].w); }
    const float ra = 1.f / sqrtf(wave_sum(sa) * (1.f / DM) + NORM_EPS), rb = 1.f / sqrtf(wave_sum(sb) * (1.f / DM) + NORM_EPS);
#pragma unroll
    for (int j = 0; j < 8; ++j) { const f32x4 gg = gr[64 * j]; const f32x4 ya = a[j] * ra * gg, yb = b[j] * rb * gg, yp = ya + yb, ym = ya - yb; v2u w;
        w.x = pk2(ya.x, ya.y); w.y = pk2(ya.z, ya.w); ((v2u*)(Hh + (size_t)t * DM))[lane + 64 * j] = w;
        w.x = pk2(yb.x, yb.y); w.y = pk2(yb.z, yb.w); ((v2u*)(Hh + (size_t)(t + 4096) * DM))[lane + 64 * j] = w;
        w.x = pk2(yp.x, yp.y); w.y = pk2(yp.z, yp.w); ((v2u*)(HPM + (size_t)t * DM))[lane + 64 * j] = w;
        w.x = pk2(ym.x, ym.y); w.y = pk2(ym.z, ym.w); ((v2u*)(HPM + (size_t)(t + 4096) * DM))[lane + 64 * j] = w; }
}
__device__ __forceinline__ void rms_pair_phase(const float* x, const float* g, bf16r* Hh, bf16r* HPM, int gw, int NGW, int lane) {
    asm volatile("" : "+v"(lane));
#pragma unroll 2
    for (int t = gw; t < SEQ / 2; t += NGW) rms_pair_row(x, g, Hh, HPM, t, lane);
}
template <bool OUTF32>
__device__ __forceinline__ void rms_phase(const float* x, const float* g, void* out, int gw, int NGW, int lane) {
    asm volatile("" : "+v"(lane));
#pragma unroll 2
    for (int m = gw; m < SEQ; m += NGW) rms_row<OUTF32>(x + (size_t)m * DM, g, OUTF32 ? (void*)((float*)out + (size_t)m * DM) : (void*)((bf16r*)out + (size_t)m * DM), lane);
}

__device__ __forceinline__ void diff_attn_unit(int h, int c, int qb, const att::bf16* PROJ, float* T, const float* table, char* lds, bool build_tab) {
    using namespace att3;
    int tid_ = threadIdx.x; asm volatile("" : "+v"(tid_));
    const int tid = tid_, wid = __builtin_amdgcn_readfirstlane(tid >> 6), lane = tid & 63, r32 = lane & 31, hi = lane >> 5, g = wid >> 1;
    float* tab = (float*)(lds + L_TAB);
    constexpr float LOG2E = 1.4426950408889634f;
    __syncthreads();
    if (build_tab) for (int i = tid; i < 2048; i += 512) tab[i] = table[t5_bucket(i - 1024) * 20 + 12 + h] * LOG2E;
    const float cL = table[15 * 20 + 12 + h] * LOG2E, cR = table[31 * 20 + 12 + h] * LOG2E;
    __syncthreads();
    const int q0 = qb * 128, qw0 = q0 + g * 32, qrow = qw0 + r32;
    const bf16* Qw = PROJ + (size_t)qrow * OD_N + h * 256 + c * 128 + hi * 8;
    const bf16* Kh = PROJ + 2048 + h * 256 + c * 128;
    const bf16* Vh = PROJ + 4096 + h * 256;
    f32x16 o[4]; float l;
    attn_core3(Qw, Kh, Vh, (long)OD_N, SEQ / 64, qrow, qw0, tab, cL, cR, lds, o, l);
    {
        int t2 = threadIdx.x; asm volatile("" : "+v"(t2));
        const int wid2 = __builtin_amdgcn_readfirstlane(t2 >> 6), lane2 = t2 & 63, r2 = lane2 & 31, hi2 = lane2 >> 5;
        float* xm = (float*)(lds + L_XM); float* li_l = (float*)(lds + L_WS) + wid2 * 64;
        if (hi2 == 0) xm[wid2 * 32 + r2] = l;
        __syncthreads();
        if (hi2 == 0) li_l[r2] = l + xm[(wid2 ^ 1) * 32 + r2];
        asm volatile("s_waitcnt lgkmcnt(0)" ::: "memory");
        float* Tw = T + (size_t)c * SEQ * DM + (size_t)(qb * 128 + (wid2 >> 1) * 32 + 4 * hi2) * DM + h * 256 + (wid2 & 1) * 128 + r2;
#pragma unroll
        for (int r = 0; r < 16; ++r) { const float rl = __builtin_amdgcn_rcpf(li_l[crow(r, hi2)]); float* Tr = Tw + (size_t)((r & 3) + 8 * (r >> 2)) * DM;
#pragma unroll
            for (int d0 = 0; d0 < 4; ++d0) Tr[d0 * 32] = o[d0][r] * rl; }
        __syncthreads();
    }
}
__device__ __forceinline__ void diff_post_row(const float* T, bf16r* CAT, const float* subg, float lam, float post, int m, int lane) {
    const f32x4* t0 = (const f32x4*)(T + (size_t)m * DM) + lane; const f32x4* t1 = (const f32x4*)(T + (size_t)SEQ * DM + (size_t)m * DM) + lane;
#pragma unroll
    for (int hh = 0; hh < 8; ++hh) {
        const f32x4 a = t0[64 * hh], b = t1[64 * hh]; const f32x4 d = a - b * lam;
        const float ss = wave_sum((d.x * d.x + d.y * d.y) + (d.z * d.z + d.w * d.w));
        const float sc = post / sqrtf(ss * (1.f / 256.f) + NORM_EPS);
        const f32x4 gg = *((const f32x4*)subg + lane); const f32x4 y = d * sc * gg;
        v2u w; w.x = pk2(y.x, y.y); w.y = pk2(y.z, y.w); *((v2u*)(CAT + (size_t)m * DM + 256 * hh) + lane) = w;
    }
}

__device__ __forceinline__ void dil_attn_unit(int head, int br, int cls, int qb, const att::bf16* QKV, bf16r* OB, float* LSE, const float* table, char* lds) {
    using namespace att;
    int tid_ = threadIdx.x; asm volatile("" : "+v"(tid_));
    const int tid = tid_, wid = __builtin_amdgcn_readfirstlane(tid >> 6), lane = tid & 63, r32 = lane & 31, hi = lane >> 5;
    const int dil = br == 0 ? 1 : (br == 1 ? 4 : 16), L = SEQ / dil;
    float* tab = (float*)(lds + LDS_TAB);
    __syncthreads();
    for (int i = tid; i < 640; i += 512) tab[i] = table[(br * 12 + head) * 640 + i];
    __syncthreads();
    const int q0 = qb * 256, qw0 = q0 + wid * 32, qrow = qw0 + r32;
    const bf16* Qw = QKV + ((size_t)qrow * dil + cls) * EV_QKV + head * 128 + hi * 8;
    const bf16* Kh = QKV + (size_t)cls * EV_QKV + 1536 + head * 128;
    const bf16* Vh = QKV + (size_t)cls * EV_QKV + 3072 + head * 128;
    f32x16 o[4]; float l, m;
    attn_core<1>(Qw, Kh, Vh, (long)EV_QKV * dil, q0 - 64, 6, L, qrow, qw0, tab, 320, 0.f, 0.f, lds, o, l, m);
    float* li_l = (float*)(lds + LDS_WS) + wid * 64;
    if (hi == 0) { li_l[r32] = l; LSE[((size_t)br * SEQ + (size_t)qrow * dil + cls) * 12 + head] = m * CL2 + log2f(l); }
    asm volatile("s_waitcnt lgkmcnt(0)" ::: "memory");
    bf16r* Ow = OB + (size_t)br * SEQ * 1536 + head * 128 + r32;
#pragma unroll
    for (int r = 0; r < 16; ++r) { const int orow = crow(r, hi); const float rl = __builtin_amdgcn_rcpf(li_l[orow]); const size_t pos = (size_t)(qw0 + orow) * dil + cls;
#pragma unroll
        for (int d0 = 0; d0 < 4; ++d0) Ow[pos * 1536 + d0 * 32] = (bf16r)f2bf(o[d0][r] * rl); }
    __syncthreads();
}
#define XB_TMO      128
#define XB_XCNT(j)  (256  + 64 * (j))
#define XB_XSUB(j)  (1280 + 64 * (j))
#define XB_XGEN(j)  (2304 + 64 * (j))
#define XB_TOP      3328
#define XB_TOPGEN   3392
#define XCD_BAR_WORDS 3456
#define XB_SPIN_CAP (1u << 22)

__device__ __forceinline__ unsigned xb_ld(unsigned* p)              { return __hip_atomic_load(p, __ATOMIC_RELAXED, __HIP_MEMORY_SCOPE_AGENT); }
__device__ __forceinline__ unsigned xb_add(unsigned* p, unsigned v) { return __hip_atomic_fetch_add(p, v, __ATOMIC_RELAXED, __HIP_MEMORY_SCOPE_AGENT); }
__device__ __forceinline__ unsigned xb_xcc_id() { return (unsigned)__builtin_amdgcn_s_getreg((3 << 11) | 20) & 0xFu; }
#define XB_SPIN(cond, bar) do { unsigned _sp = 0; while (cond) { __builtin_amdgcn_s_sleep(1); \
    if ((++_sp & 255u) == 0u) { if (xb_ld(&(bar)[XB_TMO])) break; if (_sp > XB_SPIN_CAP) { atomicAdd(&(bar)[XB_TMO], 1u); break; } } } } while (0)

struct XcdBarrier {
    unsigned* bar; unsigned x;
    volatile LAS unsigned* st;
};

__device__ __forceinline__ XcdBarrier xcd_barrier_post(unsigned* bar, volatile LAS unsigned* st) {
    XcdBarrier b; b.bar = bar; b.x = xb_xcc_id(); b.st = st;
    if (threadIdx.x == 0) (void)xb_add(&bar[XB_XCNT(b.x)], 1u);
    return b;
}
__device__ __forceinline__ void xcd_barrier_complete(unsigned* bar, unsigned x, unsigned& nloc, unsigned& nx) {
    const unsigned G = gridDim.x * gridDim.y * gridDim.z;
    unsigned sum, cnt, mine, sp = 0u;
    for (;;) {
        sum = 0u; cnt = 0u; mine = 0u;
#pragma unroll
        for (unsigned j = 0; j < 16; ++j) { const unsigned c = xb_ld(&bar[XB_XCNT(j)]); sum += c; cnt += (c > 0u) ? 1u : 0u; mine = (j == x) ? c : mine; }
        if (sum == G) break;
        __builtin_amdgcn_s_sleep(1);
        if ((++sp & 255u) == 0u) { if (xb_ld(&bar[XB_TMO])) break; if (sp > XB_SPIN_CAP) { atomicAdd(&bar[XB_TMO], 1u); break; } }
    }
    nloc = mine > 0u ? mine : 1u; nx = cnt > 0u ? cnt : 1u;
}

__device__ __forceinline__ void xcd_barrier(const XcdBarrier& b) {
    asm volatile("s_waitcnt vmcnt(0)" ::: "memory");
    __syncthreads();
    if (threadIdx.x == 0) {
        unsigned* bar = b.bar;
        __builtin_amdgcn_s_waitcnt(0);
        unsigned nloc = b.st[0], nx = b.st[1];
        if (nloc == 0u) { xcd_barrier_complete(bar, b.x, nloc, nx); b.st[0] = nloc; b.st[1] = nx; }
        const unsigned old = xb_add(&bar[XB_XSUB(b.x)], 1u);
        const unsigned gen = old / nloc;
        if (old + 1u == (gen + 1u) * nloc) {
            __builtin_amdgcn_fence(__ATOMIC_RELEASE, "agent");
            asm volatile("s_waitcnt vmcnt(0)" ::: "memory");
            const unsigned og = xb_add(&bar[XB_TOP], 1u);
            const unsigned tg = og / nx;
            if (og + 1u == (tg + 1u) * nx) xb_add(&bar[XB_TOPGEN], 1u);
            else XB_SPIN(xb_ld(&bar[XB_TOPGEN]) == tg, bar);
            __builtin_amdgcn_fence(__ATOMIC_ACQUIRE, "agent");
            xb_add(&bar[XB_XGEN(b.x)], 1u);
            asm volatile("s_waitcnt vmcnt(0)" ::: "memory");
        } else {
            XB_SPIN(xb_ld(&bar[XB_XGEN(b.x)]) == gen, bar);
            __builtin_amdgcn_fence(__ATOMIC_ACQUIRE, "agent");
            asm volatile("s_waitcnt vmcnt(0)" ::: "memory");
        }
    }
    __syncthreads();
}

#ifndef PROBE_ATT
#define PROBE_ATT 1
#endif
#ifndef PROBE_P0
#define PROBE_P0 1
#endif
#ifndef PROBE_FF1
#define PROBE_FF1 1
#endif
#ifndef PROBE_DIL
#define PROBE_DIL 1
#endif
#ifndef PROBE_SYNC
#define PROBE_SYNC 1
#endif
#define GSYNC() do { for (int rs_ = 0; rs_ < PROBE_SYNC; ++rs_) { XcdBarrier xb_; xb_.bar = (unsigned*)(args.ws + WS_CTL); xb_.x = xb_xcc_id(); xb_.st = (volatile LAS unsigned*)(ldsl + XB_LDS_OFF); xcd_barrier(xb_); } } while (0)
__global__ void __launch_bounds__(512, 2) mega_fwd(Args args) {
    extern __shared__ __attribute__((aligned(16))) unsigned char lds[];
    cg::grid_group grid = cg::this_grid();
    const int tid = threadIdx.x, lane = tid & 63, wave = __builtin_amdgcn_readfirstlane(tid >> 6);
    const int G = gridDim.x, bx = blockIdx.x;
    const int gw = bx * 8 + wave, NGW = G * 8;
    unsigned char* ws = args.ws;
    LAS unsigned char* ldsl = (LAS unsigned char*)lds;
    const float* x_in = args.in[0]; const float* g_mix = args.in[1]; const float* g_ffn = args.in[2]; const float* g_fin = args.in[3];
    const float* table = args.in[4]; const float* w_in_e = args.in[5]; const float* w_fnet = args.in[6];
    float* out = args.out;
    bf16r* H = (bf16r*)(ws + WS_H); bf16r* CAT = (bf16r*)(ws + WS_CAT); float* WCS = (float*)(ws + WS_WCS);
    bf16r* DFT = (bf16r*)(ws + WS_DFT);
    volatile LAS unsigned* xst = (volatile LAS unsigned*)(ldsl + XB_LDS_OFF);
    if (tid < 2) xst[tid] = 0u;
    unsigned* xwords = (unsigned*)(ws + WS_CTL);
    if (bx == 0) for (int i = tid; i < XCD_BAR_WORDS; i += 512) __hip_atomic_store(xwords + i, 0u, __ATOMIC_RELAXED, __HIP_MEMORY_SCOPE_AGENT);
    __syncthreads();
    grid.sync();
    (void)xcd_barrier_post(xwords, xst);

#ifndef SKIP_P0
    for (int rep0_ = 0; rep0_ < PROBE_P0; ++rep0_)
    {
        LAS float* scr = (LAS float*)(ldsl + wave * 16384);
        int jb = 0;
        for (int it = gw; it < TJ_TOTAL; it += NGW) {
            while (it >= g_jobs[jb].items_end) ++jb;
            const TJob J = g_jobs[jb]; const int start = jb == 0 ? 0 : g_jobs[jb - 1].items_end;
            transpose_item(args.in[J.in_idx] + J.src_off, J.ldw, J.K, J.ncols, (bf16r*)(ws + J.dst_off), scr, it - start, lane, J.qcols);
        }
        { float* DT = (float*)(ws + WS_DTAB);
          for (int idx = bx * 512 + tid; idx < 36 * 640; idx += G * 512) { const int hb = idx / 640, i = idx - hb * 640, o = i - 320, br_ = hb / 12, head_ = hb - br_ * 12; const int dil_ = br_ == 0 ? 1 : (br_ == 1 ? 4 : 16);
              DT[idx] = (o >= -64 && o <= 64) ? table[att::t5_bucket(o * dil_) * 20 + head_] * (1.f / att::SCALE) : att::NEGBIG; } }
        for (int idx = bx * 512 + tid; idx < 2 * 4 * 128 * 256; idx += G * 512) {
            const int j = idx & 255, c = (idx >> 8) & 127, lg = idx >> 15, e = j & 127;
            const float* wf = w_fnet + (size_t)lg * 128 * 128 + e; float s = 0.f;
            for (int cp = 0; cp < 128; ++cp) { const float ph = (float)((c * cp) & 127) * (1.f / 128.f); const float tr = (j < 128) ? __builtin_amdgcn_cosf(ph) : __builtin_amdgcn_sinf(ph); s += tr * wf[cp * 128]; }
            WCS[idx] = s * (1.f / 1024.f);
        }
        for (long v = (long)bx * 512 + tid; v < (long)SEQ * 1024; v += (long)G * 512) {
            const int r = (int)(v >> 10), k0 = ((int)v & 1023) * 8; const int sp = ((r & 4095) << 1) | (r >> 12); const bool is_sin = k0 >= 4096; const int kk = k0 & 4095;
            float t[8];
#pragma unroll
            for (int i = 0; i < 8; ++i) { const float ph = (float)((sp * (kk + i)) & 8191) * (1.f / 8192.f); t[i] = is_sin ? -__builtin_amdgcn_sinf(ph) : __builtin_amdgcn_cosf(ph); }
            v4u o; o.x = pk2(t[0], t[1]); o.y = pk2(t[2], t[3]); o.z = pk2(t[4], t[5]); o.w = pk2(t[6], t[7]);
            *(v4u*)(DFT + (size_t)r * 8192 + k0) = o;
        }
        rms_pair_phase(x_in, g_mix, H, (bf16r*)(ws + WS_HPM), gw, NGW, lane);
    }
    GSYNC();
    for (int item = bx; item < 2 * 4 * 32; item += G) {
        const int l = item >> 7, g = (item >> 5) & 3, k0 = (item & 31) * 64;
        LAS float* As = (LAS float*)ldsl;
        __syncthreads();
        for (int i = 0; i < 16; ++i) { const int c = tid & 127, kk = (tid >> 7) + 4 * i; As[c * 68 + kk] = w_in_e[((size_t)l * 2048 + k0 + kk) * 5120 + 4608 + g * 128 + c]; }
        __syncthreads();
        const int j = tid & 255, kh = tid >> 8;
        float acc[32];
#pragma unroll
        for (int i = 0; i < 32; ++i) acc[i] = 0.f;
        const float* wc = WCS + ((size_t)(l * 4 + g) * 128) * 256 + j;
        for (int c = 0; c < 128; ++c) { const float w = wc[c * 256];
#pragma unroll
            for (int q = 0; q < 8; ++q) { const f32x4 a4 = *(const LAS f32x4*)(As + c * 68 + kh * 32 + 4 * q); acc[4 * q] += a4.x * w; acc[4 * q + 1] += a4.y * w; acc[4 * q + 2] += a4.z * w; acc[4 * q + 3] += a4.w * w; } }
        bf16r* dst = (bf16r*)(ws + WS_WIN_E + (size_t)l * 22 * MiB) + (size_t)(4608 + (j >> 7) * 512 + g * 128 + (j & 127)) * 2048 + k0 + kh * 32;
#pragma unroll
        for (int q = 0; q < 4; ++q) { v4u o; o.x = pk2(acc[8 * q], acc[8 * q + 1]); o.y = pk2(acc[8 * q + 2], acc[8 * q + 3]); o.z = pk2(acc[8 * q + 4], acc[8 * q + 5]); o.w = pk2(acc[8 * q + 6], acc[8 * q + 7]); *(v4u*)(dst + 8 * q) = o; }
    }
    GSYNC();
#endif

#pragma unroll 1
    for (int layer = 0; layer < NLAYER; ++layer) {
        const int lj = layer >> 1; const bool even = (layer & 1) == 0;
        const float* resid_base = (layer == 0) ? x_in : out;
        if (even) {
            const bf16r* WIN = (const bf16r*)(ws + WS_WIN_E + (size_t)lj * 22 * MiB);
            bf16r* QKV = (bf16r*)(ws + WS_PROJ); bf16r* YT = (bf16r*)(ws + WS_YT);
            { pg8::Gemm g{H, WIN, DM, DM, DM}; pg8::Order S; S.init(SEQ, EV_QKV, 1, G, bx);
              pg8::EpiBf16<0, false> E{QKV, EV_QKV, 0};
#ifndef SKIP_G0
              pg8::gemm_phase<pg8::EpiBf16<0, false>, pg8::Order, true, true>(ldsl, g, S, E);
#endif
            }
            { pg8::Gemm g{WIN + (size_t)EV_QKV * DM, (const bf16r*)(ws + WS_HPM), DM, DM, DM}; pg8::Order S; S.init(1024, SEQ, 1, G, (bx + G / 2) % G);
              pg8::EpiBf16<0, true> E{YT, 16384, 4096};
#ifndef SKIP_G1
              pg8::gemm_phase<pg8::EpiBf16<0, true>, pg8::Order, true, true>(ldsl, g, S, E);
#endif
            }
            GSYNC();
            { pg8::Gemm g{DFT, YT, 8192, 16384, 2048, 16, 8192}; pg8::Order S; S.init(SEQ, 512, 4, G, bx);
              pg8::EpiPart E{(float*)(ws + WS_PART), 512, (size_t)SEQ * 512};
#ifndef SKIP_G2
              pg8::gemm_phase<pg8::EpiPart, pg8::Order, true, true>(ldsl, g, S, E);
#endif
            }
            for (int rep2_ = 0; rep2_ < PROBE_DIL; ++rep2_)
            for (int u = bx; u < 12 * 3 * 32; u += G) {
                const int qbc = u & 31, hb = u >> 5, head = hb % 12, br = hb / 12; const int nqb = br == 0 ? 32 : (br == 1 ? 8 : 2);
#ifndef SKIP_DIL
                dil_attn_unit(head, br, qbc / nqb, qbc % nqb, (const att::bf16*)QKV, (bf16r*)(ws + WS_OB), (float*)(ws + WS_LSE), (const float*)(ws + WS_DTAB), (char*)lds);
#endif
            }
            GSYNC();
            {
                const bf16r* OB = (const bf16r*)(ws + WS_OB); const float* LSE = (const float*)(ws + WS_LSE); const float* PART = (const float*)(ws + WS_PART);
                int lane_m = lane; asm volatile("" : "+v"(lane_m));
#pragma unroll 2
                for (int m = gw; m < SEQ; m += NGW) {
#pragma unroll
                    for (int i = 0; i < 3; ++i) { const int v = lane_m + 64 * i, head = v >> 4;
                        const float l0 = LSE[((size_t)0 * SEQ + m) * 12 + head], l1 = LSE[((size_t)1 * SEQ + m) * 12 + head], l2 = LSE[((size_t)2 * SEQ + m) * 12 + head];
                        const float mx = fmaxf(l0, fmaxf(l1, l2)); float w0 = __builtin_amdgcn_exp2f(l0 - mx), w1 = __builtin_amdgcn_exp2f(l1 - mx), w2 = __builtin_amdgcn_exp2f(l2 - mx);
                        const float inv = 1.f / (w0 + w1 + w2); w0 *= inv; w1 *= inv; w2 *= inv;
                        const v4u a = *(const v4u*)(OB + ((size_t)0 * SEQ + m) * 1536 + v * 8), b = *(const v4u*)(OB + ((size_t)1 * SEQ + m) * 1536 + v * 8), c = *(const v4u*)(OB + ((size_t)2 * SEQ + m) * 1536 + v * 8);
                        v4u o;
#pragma unroll
                        for (int q = 0; q < 4; ++q) { const float lo = w0 * bf2f((unsigned short)(a[q] & 0xffff)) + w1 * bf2f((unsigned short)(b[q] & 0xffff)) + w2 * bf2f((unsigned short)(c[q] & 0xffff));
                            const float hi2 = w0 * bf2f((unsigned short)(a[q] >> 16)) + w1 * bf2f((unsigned short)(b[q] >> 16)) + w2 * bf2f((unsigned short)(c[q] >> 16)); o[q] = pk2(lo, hi2); }
                        *(v4u*)(CAT + (size_t)m * DM + v * 8) = o; }
                    { f32x4 s0 = (f32x4){0.f, 0.f, 0.f, 0.f}, s1 = s0;
#pragma unroll
                      for (int kc = 0; kc < 4; ++kc) { const float* p = PART + ((size_t)kc * SEQ + m) * 512 + lane_m * 8; s0 += *(const f32x4*)p; s1 += *(const f32x4*)(p + 4); }
                      v4u o; o.x = pk2(s0.x, s0.y); o.y = pk2(s0.z, s0.w); o.z = pk2(s1.x, s1.y); o.w = pk2(s1.z, s1.w);
                      *(v4u*)(CAT + (size_t)m * DM + 1536 + lane_m * 8) = o; }
                }
            }
            GSYNC();
        } else {
            const bf16r* WQ = (const bf16r*)(ws + WS_WQKV_O + (size_t)lj * 24 * MiB);
            bf16r* PROJ = (bf16r*)(ws + WS_PROJ);
            { pg8::Gemm g{H, WQ, DM, DM, DM}; pg8::Order S; S.init(SEQ, OD_N, 1, G, bx);
              pg8::EpiBf16<0, false> E{PROJ, OD_N, 0};
#ifndef SKIP_G3
              pg8::gemm_phase<pg8::EpiBf16<0, false>, pg8::Order, true, true>(ldsl, g, S, E);
#endif
            }
            GSYNC();
            for (int rep_ = 0; rep_ < PROBE_ATT; ++rep_)
            for (int u = bx; u < 1024; u += G) {
#ifndef SKIP_DIFF
                diff_attn_unit(u & 7, u >> 9, (u >> 3) & 63, (const att::bf16*)PROJ, (float*)(ws + WS_T), table, (char*)lds, (u == bx) || (G & 7) != 0);
#endif
            }
            GSYNC();
            {
                const float lambda_init = (layer == 1) ? 0.3555090676f : 0.5560582042f;
                int lane_p = lane; asm volatile("" : "+v"(lane_p));
                const float* lq1 = args.in[9] + lj * 128; const float* lk1 = args.in[10] + lj * 128; const float* lq2 = args.in[11] + lj * 128; const float* lk2 = args.in[12] + lj * 128;
                const float sa = wave_sum(lq1[lane_p] * lk1[lane_p] + lq1[lane_p + 64] * lk1[lane_p + 64]);
                const float sb = wave_sum(lq2[lane_p] * lk2[lane_p] + lq2[lane_p + 64] * lk2[lane_p + 64]);
                const float lam = expf(sa) - expf(sb) + lambda_init;
#pragma unroll 2
                for (int m = gw; m < SEQ; m += NGW) diff_post_row((const float*)(ws + WS_T), CAT, args.in[13] + lj * 256, lam, 1.f - lambda_init, m, lane_p);
            }
            GSYNC();
        }
        { pg8::Gemm g{CAT, (const bf16r*)(ws + WS_WOUT + (size_t)layer * 8 * MiB), DM, DM, DM}; pg8::Order S; S.init(SEQ, DM, 1, G, bx);
          pg8::EpiRes E{resid_base, out, DM};
#ifndef SKIP_G4
          pg8::gemm_phase<pg8::EpiRes, pg8::Order, true, true>(ldsl, g, S, E);
#endif
            }
        GSYNC();
        rms_phase<false>(out, g_ffn + layer * DM, H, gw, NGW, lane);
        GSYNC();
        for (int rep1_ = 0; rep1_ < PROBE_FF1; ++rep1_) { pg8::Gemm g{H, (const bf16r*)(ws + WS_WFF1 + (size_t)layer * 32 * MiB), DM, DM, DM}; pg8::Order S; S.init(SEQ, DFF, 1, G, bx);
          pg8::EpiBf16<2, false> E{(bf16r*)(ws + WS_HID), DFF, 0};
#ifndef SKIP_G5
          pg8::gemm_phase<pg8::EpiBf16<2, false>, pg8::Order, true, true>(ldsl, g, S, E);
#endif
            }
        GSYNC();
        { pg8::Gemm g{(const bf16r*)(ws + WS_HID), (const bf16r*)(ws + WS_WFF2 + (size_t)layer * 32 * MiB), DFF, DFF, DFF}; pg8::Order S; S.init(SEQ, DM, 1, G, bx);
          pg8::EpiRes E{out, out, DM};
#ifndef SKIP_G6
          pg8::gemm_phase<pg8::EpiRes, pg8::Order, true, true>(ldsl, g, S, E);
#endif
            }
        GSYNC();
        if (layer < NLAYER - 1) { if (layer & 1) rms_pair_phase(out, g_mix + (layer + 1) * DM, H, (bf16r*)(ws + WS_HPM), gw, NGW, lane); else rms_phase<false>(out, g_mix + (layer + 1) * DM, H, gw, NGW, lane); GSYNC(); }
        else rms_phase<true>(out, g_fin, out, gw, NGW, lane);
    }
}

extern "C" void kernel_launch(void* const* d_in, const int* in_sizes, int n_in, void* d_out, int out_size, void* d_ws, size_t ws_size, hipStream_t stream) {
    static int grid = 0;
    if (grid == 0) {
        if (n_in != 17 || out_size != SEQ * DM || ws_size < WS_TOTAL) { fprintf(stderr, "kernel_launch: unexpected shapes: n_in %d out %d ws %zu (need %zu)\n", n_in, out_size, ws_size, (size_t)WS_TOTAL); grid = -1; return; }
        int dev = 0, cus = 0, per_cu = 0;
        (void)hipGetDevice(&dev); (void)hipDeviceGetAttribute(&cus, hipDeviceAttributeMultiprocessorCount, dev);
        if (hipFuncSetAttribute((const void*)mega_fwd, hipFuncAttributeMaxDynamicSharedMemorySize, LDS_BYTES) != hipSuccess) { fprintf(stderr, "kernel_launch: hipFuncSetAttribute failed\n"); grid = -1; return; }
        if (hipOccupancyMaxActiveBlocksPerMultiprocessor(&per_cu, (const void*)mega_fwd, 512, LDS_BYTES) != hipSuccess || per_cu < 1) { fprintf(stderr, "kernel_launch: occupancy query says %d\n", per_cu); per_cu = 1; }
        (void)hipGetLastError();
        grid = cus * per_cu;
    }
    if (grid < 0) return;
    Args a{};
    for (int i = 0; i < 17; ++i) a.in[i] = (const float*)d_in[i];
    a.out = (float*)d_out; a.ws = (unsigned char*)d_ws;
    void* kargs[] = {&a};
    const hipError_t e = hipLaunchCooperativeKernel((const void*)mega_fwd, dim3(grid), dim3(512), kargs, LDS_BYTES, stream);
    if (e != hipSuccess) fprintf(stderr, "kernel_launch: cooperative launch failed: %s (grid %d)\n", hipGetErrorString(e), grid);
}
```

```cpp
#include <hip/hip_runtime.h>
#include <hip/hip_bf16.h>
#include <hip/hip_cooperative_groups.h>
#include <cstdio>
#include <cstdint>
namespace cg = cooperative_groups;

namespace pg8 {
#define PG8_LAS __attribute__((address_space(3)))
typedef unsigned short bf16_t;
typedef short bf16x8 __attribute__((ext_vector_type(8)));
typedef float f32x4 __attribute__((ext_vector_type(4)));
typedef unsigned u32x4 __attribute__((ext_vector_type(4)));
constexpr int BM = 256, BK = 64, HALF = 128, HTB = HALF * BK * 2  , STAGE_BYTES = 8 * HTB, NXCD = 8, WGM = 8;

__host__ __device__ __forceinline__ int lds_byte(int r, int c) { const int st = (r >> 4) * 2 + (c >> 5), rr = r & 15, cc = c & 31, ob = rr * 64 + cc * 2; return st * 1024 + (ob ^ (((ob >> 9) & 1) << 5)); }
__host__ __device__ __forceinline__ void stage_rc(int b, int& R, int& C) { const int st = b / 1024, sb = b % 1024, swz = sb ^ (((sb >> 9) & 1) << 5); R = (st >> 1) * 16 + swz / 64; C = (st & 1) * 32 + (swz % 64) / 2; }
__host__ __device__ __forceinline__ int perm32(int rho) { const int n = rho >> 4, i = rho & 15; return 8 * (i >> 2) + 4 * n + (i & 3); }

struct Unit { int pm, pn, kc; };
struct Gemm { const bf16_t* A; const bf16_t* Bt; int lda, ldb, K; int bsplit_pm = 1 << 30; int bsplit_off = 0; };

struct Order {
    int nM, nN, nK, nwg, tot, G, c;
    __device__ void init(int M, int N, int nK_, int G_, int c_) { nM = M / BM; nN = N / BM; nK = nK_; nwg = nM * nN; tot = nwg * nK; G = G_; c = c_; }
    __device__ bool next(int i, Unit& u) const {
        const long L = (long)i * G + c; if (L >= tot) return false;
        const int kc = (int)(L / nwg); int wgid = (int)(L % nwg);
        { const int q = nwg / NXCD, r = nwg % NXCD, xcd = wgid % NXCD, off = wgid / NXCD; wgid = (xcd < r ? xcd * (q + 1) : r * (q + 1) + (xcd - r) * q) + off; }
        const int nig = WGM * nN, gid = wgid / nig, fm = gid * WGM, gsz = (nM - fm) < WGM ? (nM - fm) : WGM;
        u.pm = fm + ((wgid % nig) % gsz); u.pn = (wgid % nig) / gsz; u.kc = kc; return true;
    }
    __device__ __forceinline__ void a_ready(const Unit&) const {}
    __device__ __forceinline__ void done(const Unit&) const {}
};

__device__ __forceinline__ unsigned cvt_pk_bf16(float lo, float hi) { unsigned r; asm volatile("v_cvt_pk_bf16_f32 %0, %1, %2" : "=v"(r) : "v"(lo), "v"(hi)); return r; }

template <int ACT, bool YSPLIT> struct EpiBf16 {
    static constexpr bool PERM = true, AFTER_DRAIN = false;
    bf16_t* O; int ldc; int ysplit_cols;
    __device__ __forceinline__ void operator()(const f32x4 (&acc)[2][2][4][2], const Unit& u, int wr, int wc, int fr, int fq) const {
        int rowt = u.pm * BM, colt = u.pn * BM;
        if (YSPLIT) { rowt = (u.pm & 1) * BM; colt = (u.pn >> 4) * (2 * ysplit_cols) + (u.pm >> 1) * ysplit_cols + (u.pn & 15) * BM; }
        const int row0 = rowt + wr * 64 + fr; const int col0 = colt + wc * 32 + 8 * fq;
#pragma unroll
        for (int ai = 0; ai < 2; ++ai)
#pragma unroll
            for (int m = 0; m < 4; ++m) { bf16_t* rowp = O + (size_t)(row0 + ai * HALF + m * 16) * ldc + col0;
#pragma unroll
                for (int bj = 0; bj < 2; ++bj) { f32x4 v0 = acc[ai][bj][m][0], v1 = acc[ai][bj][m][1];
                    if (ACT == 2) {
#pragma unroll
                        for (int q = 0; q < 4; ++q) { const float a = fmaxf(v0[q], 0.f), b = fmaxf(v1[q], 0.f); v0[q] = a * a; v1[q] = b * b; } }
                    u32x4 w; w.x = cvt_pk_bf16(v0[0], v0[1]); w.y = cvt_pk_bf16(v0[2], v0[3]); w.z = cvt_pk_bf16(v1[0], v1[1]); w.w = cvt_pk_bf16(v1[2], v1[3]);
                    *(u32x4*)(rowp + bj * HALF) = w; } }
    }
};
struct EpiRes {
    static constexpr bool PERM = true, AFTER_DRAIN = false;
    const float* base; float* out; int ldc;
    __device__ __forceinline__ void operator()(const f32x4 (&acc)[2][2][4][2], const Unit& u, int wr, int wc, int fr, int fq) const {
        const int col0 = u.pn * BM + wc * 32 + 8 * fq;
#pragma unroll
        for (int ai = 0; ai < 2; ++ai)
#pragma unroll
            for (int m = 0; m < 4; ++m) { const size_t off = (size_t)(u.pm * BM + ai * HALF + wr * 64 + m * 16 + fr) * ldc + col0;
#pragma unroll
                for (int bj = 0; bj < 2; ++bj) { const f32x4 b0 = *(const f32x4*)(base + off + bj * HALF), b1 = *(const f32x4*)(base + off + bj * HALF + 4);
                    *(f32x4*)(out + off + bj * HALF) = b0 + acc[ai][bj][m][0]; *(f32x4*)(out + off + bj * HALF + 4) = b1 + acc[ai][bj][m][1]; }
                asm volatile("" ::: "memory"); }
    }
};
struct EpiPart {
    static constexpr bool PERM = true, AFTER_DRAIN = false;
    float* out; int ldc; size_t kstride;
    __device__ __forceinline__ void operator()(const f32x4 (&acc)[2][2][4][2], const Unit& u, int wr, int wc, int fr, int fq) const {
        const int col0 = u.pn * BM + wc * 32 + 8 * fq; float* o = out + (size_t)u.kc * kstride;
#pragma unroll
        for (int ai = 0; ai < 2; ++ai)
#pragma unroll
            for (int m = 0; m < 4; ++m) { const int r = u.pm * BM + ai * HALF + wr * 64 + m * 16 + fr; const size_t off = (size_t)(((r & 4095) << 1) | (r >> 12)) * ldc + col0;
#pragma unroll
                for (int bj = 0; bj < 2; ++bj) { *(f32x4*)(o + off + bj * HALF) = acc[ai][bj][m][0]; *(f32x4*)(o + off + bj * HALF + 4) = acc[ai][bj][m][1]; } }
    }
};

template <class Epi, class Sched, bool ALIGN_EPI = false, bool SP2 = false>
__device__ __forceinline__ void gemm_phase(PG8_LAS unsigned char* lds, const Gemm g, const Sched& S, const Epi& E) {
    int tid_ = threadIdx.x; asm volatile("" : "+v"(tid_));
    const int tid = tid_, wid = __builtin_amdgcn_readfirstlane(tid >> 6), lane = tid & 63, wr = wid >> 2, wc = wid & 3, fr = lane & 15, fq = lane >> 4;
    const int K = g.K, nt = K / BK;
    unsigned voffA[2], voffB[2];
#pragma unroll
    for (int i = 0; i < 2; ++i) { int R, C; stage_rc(tid * 16 + i * 8192, R, C); const int Rb = Epi::PERM ? ((R & ~31) + perm32(R & 31)) : R;
        voffA[i] = (unsigned)(R * g.lda + C) * 2u; voffB[i] = (unsigned)(Rb * g.ldb + C) * 2u; }
    const size_t kstep = (size_t)(BK * 2);
    const size_t hstepA = (size_t)HALF * g.lda * 2, hstepB = (size_t)HALF * g.ldb * 2;
    const size_t tstepA = 2 * hstepA, tstepB = 2 * hstepB; const size_t ksplit = (size_t)K * 2;
    const unsigned ldsw = (unsigned)wid * 1024u;
    const int aoff = lds_byte(wr * 64 + fr, fq * 8), boff = lds_byte(wc * 32 + fr, fq * 8);
#define PG8_SA(b, h) (((b) * 2 + (h)) * HTB)
#define PG8_SB(b, h) ((4 + (b) * 2 + (h)) * HTB)
#define PG8_STAGE(bufoff, gbase, voff) do { _Pragma("unroll") for (int _i = 0; _i < 2; ++_i) \
        __builtin_amdgcn_global_load_lds((const unsigned*)((const char*)(gbase) + (voff)[_i]), (PG8_LAS unsigned*)(lds + (bufoff) + ldsw + _i * 8192), 16, 0, 0); } while (0)
#define PG8_LDA(dst, b, h) do { _Pragma("unroll") for (int m = 0; m < 4; ++m) _Pragma("unroll") for (int k = 0; k < 2; ++k) dst[m][k] = *(const PG8_LAS bf16x8*)(lds + PG8_SA(b, h) + aoff + m * 2048 + k * 1024); } while (0)
#define PG8_LDB(dst, b, h) do { _Pragma("unroll") for (int n = 0; n < 2; ++n) _Pragma("unroll") for (int k = 0; k < 2; ++k) dst[n][k] = *(const PG8_LAS bf16x8*)(lds + PG8_SB(b, h) + boff + n * 2048 + k * 1024); } while (0)
#define PG8_MMA(ai, bj, At, Bt) do { __builtin_amdgcn_s_setprio(1); _Pragma("unroll") for (int m = 0; m < 4; ++m) _Pragma("unroll") for (int n = 0; n < 2; ++n) _Pragma("unroll") for (int k = 0; k < 2; ++k) \
        acc[ai][bj][m][n] = __builtin_amdgcn_mfma_f32_16x16x32_bf16(Bt[n][k], At[m][k], acc[ai][bj][m][n], 0, 0, 0); __builtin_amdgcn_s_setprio(0); } while (0)
#define PG8_WAIT_V(n) asm volatile("s_waitcnt vmcnt(" #n ")" ::: "memory")
#define PG8_WAIT_L(n) asm volatile("s_waitcnt lgkmcnt(" #n ")" ::: "memory")
#define PG8_BAR __builtin_amdgcn_s_barrier()
#define PG8_SCHED __builtin_amdgcn_sched_barrier(0)
    Unit cur, nxt; int ui = 0;
    if (!S.next(0, cur)) return;
    f32x4 acc[2][2][4][2];
#pragma unroll
    for (int a = 0; a < 2; ++a)
#pragma unroll
        for (int b = 0; b < 2; ++b)
#pragma unroll
            for (int m = 0; m < 4; ++m)
#pragma unroll
                for (int n = 0; n < 2; ++n) acc[a][b][m][n] = (f32x4){0.f, 0.f, 0.f, 0.f};
    bf16x8 At[4][2], B0[2][2], B1[2][2];
    const char* cA = (const char*)g.A + (size_t)cur.pm * tstepA + (size_t)cur.kc * ksplit; const char* cB = (const char*)g.Bt + (size_t)cur.pn * tstepB + (size_t)cur.kc * ksplit + (cur.pm >= g.bsplit_pm ? (size_t)g.bsplit_off * 2 : (size_t)0);
    S.a_ready(cur);
    if constexpr (SP2) {
        PG8_STAGE(PG8_SB(0, 0), cB, voffB); PG8_STAGE(PG8_SB(0, 1), cB + hstepB, voffB); PG8_STAGE(PG8_SA(0, 0), cA, voffA); PG8_STAGE(PG8_SA(0, 1), cA + hstepA, voffA);
        if (wr == 1) PG8_BAR;
        PG8_WAIT_V(2); PG8_BAR;
        PG8_STAGE(PG8_SB(1, 0), cB + kstep, voffB); PG8_STAGE(PG8_SA(1, 0), cA + kstep, voffA); PG8_STAGE(PG8_SB(1, 1), cB + hstepB + kstep, voffB);
        PG8_WAIT_V(6); PG8_BAR;
    } else {
        PG8_STAGE(PG8_SB(0, 0), cB, voffB); PG8_STAGE(PG8_SA(0, 0), cA, voffA); PG8_STAGE(PG8_SB(0, 1), cB + hstepB, voffB); PG8_STAGE(PG8_SA(0, 1), cA + hstepA, voffA);
        if (wr == 1) PG8_BAR;
        PG8_WAIT_V(4); PG8_BAR;
        PG8_STAGE(PG8_SB(1, 0), cB + kstep, voffB); PG8_STAGE(PG8_SA(1, 0), cA + kstep, voffA); PG8_STAGE(PG8_SB(1, 1), cB + hstepB + kstep, voffB);
        PG8_WAIT_V(6); PG8_BAR;
    }
    for (;;) {
        const bool has_next = S.next(ui + 1, nxt);
        const char* nA = has_next ? (const char*)g.A + (size_t)nxt.pm * tstepA + (size_t)nxt.kc * ksplit : cA; const char* nB = has_next ? (const char*)g.Bt + (size_t)nxt.pn * tstepB + (size_t)nxt.kc * ksplit + (nxt.pm >= g.bsplit_pm ? (size_t)g.bsplit_off * 2 : (size_t)0) : cB;
        for (int t = 0; t < nt; t += 2) {
            const bool last = (t == nt - 2);
            const char* a1 = cA + (size_t)(t + 1) * kstep;
            const char* a2 = last ? nA : cA + (size_t)(t + 2) * kstep; const char* b2 = last ? nB : cB + (size_t)(t + 2) * kstep;
            const char* a3 = a2 + kstep; const char* b3 = b2 + kstep;
            if (last && has_next) S.a_ready(nxt);
            if constexpr (SP2) {
            PG8_LDB(B0, 0, 0); PG8_LDB(B1, 0, 1); PG8_SCHED; PG8_LDA(At, 0, 0); PG8_STAGE(PG8_SA(1, 1), a1 + hstepA, voffA);
            PG8_WAIT_V(8); PG8_WAIT_L(0); PG8_BAR; PG8_MMA(0, 0, At, B0); PG8_MMA(0, 1, At, B1); PG8_BAR; PG8_SCHED;
            PG8_LDA(At, 0, 1); PG8_STAGE(PG8_SB(0, 0), b2, voffB); PG8_STAGE(PG8_SB(0, 1), b2 + hstepB, voffB); PG8_STAGE(PG8_SA(0, 0), a2, voffA);
            PG8_WAIT_V(8); PG8_WAIT_L(0); PG8_BAR; PG8_MMA(1, 0, At, B0); PG8_MMA(1, 1, At, B1); PG8_BAR; PG8_SCHED;
            PG8_LDB(B0, 1, 0); PG8_LDB(B1, 1, 1); PG8_SCHED; PG8_LDA(At, 1, 0); PG8_STAGE(PG8_SA(0, 1), a2 + hstepA, voffA);
            PG8_WAIT_V(8); PG8_WAIT_L(0); PG8_BAR; PG8_MMA(0, 0, At, B0); PG8_MMA(0, 1, At, B1); PG8_BAR; PG8_SCHED;
            PG8_LDA(At, 1, 1); PG8_STAGE(PG8_SB(1, 0), b3, voffB); PG8_STAGE(PG8_SB(1, 1), b3 + hstepB, voffB); PG8_STAGE(PG8_SA(1, 0), a3, voffA);
            PG8_WAIT_V(8); PG8_WAIT_L(0); PG8_BAR; PG8_MMA(1, 0, At, B0); PG8_MMA(1, 1, At, B1); PG8_BAR; PG8_SCHED;
            } else {
            PG8_LDB(B0, 0, 0); PG8_SCHED; PG8_LDA(At, 0, 0); PG8_STAGE(PG8_SA(1, 1), a1 + hstepA, voffA);
            PG8_WAIT_L(8); PG8_BAR; PG8_WAIT_L(0); PG8_MMA(0, 0, At, B0); PG8_BAR; PG8_SCHED;
            PG8_LDB(B1, 0, 1); PG8_STAGE(PG8_SB(0, 0), b2, voffB);
            PG8_BAR; PG8_WAIT_L(0); PG8_MMA(0, 1, At, B1); PG8_BAR;
            PG8_LDA(At, 0, 1); PG8_STAGE(PG8_SA(0, 0), a2, voffA);
            PG8_BAR; PG8_WAIT_L(0); PG8_MMA(1, 0, At, B0); PG8_BAR; PG8_SCHED;
            PG8_STAGE(PG8_SB(0, 1), b2 + hstepB, voffB);
            PG8_WAIT_V(6); PG8_BAR; PG8_MMA(1, 1, At, B1); PG8_BAR;
            PG8_LDB(B0, 1, 0); PG8_SCHED; PG8_LDA(At, 1, 0); PG8_STAGE(PG8_SA(0, 1), a2 + hstepA, voffA);
            PG8_WAIT_L(8); PG8_BAR; PG8_WAIT_L(0); PG8_MMA(0, 0, At, B0); PG8_BAR; PG8_SCHED;
            PG8_LDB(B1, 1, 1); PG8_STAGE(PG8_SB(1, 0), b3, voffB);
            PG8_BAR; PG8_WAIT_L(0); PG8_MMA(0, 1, At, B1); PG8_BAR;
            PG8_LDA(At, 1, 1); PG8_STAGE(PG8_SA(1, 0), a3, voffA);
            PG8_BAR; PG8_WAIT_L(0); PG8_MMA(1, 0, At, B0); PG8_BAR; PG8_SCHED;
            PG8_STAGE(PG8_SB(1, 1), b3 + hstepB, voffB);
            PG8_WAIT_V(6); PG8_BAR; PG8_MMA(1, 1, At, B1); PG8_BAR;
            }
        }
        if constexpr (ALIGN_EPI) { if (wr == 0) PG8_BAR; }
        if constexpr (!Epi::AFTER_DRAIN) { E(acc, cur, wr, wc, fr, fq); S.done(cur); }
        if (!has_next) break;
#pragma unroll
        for (int a = 0; a < 2; ++a)
#pragma unroll
            for (int b = 0; b < 2; ++b)
#pragma unroll
                for (int m = 0; m < 4; ++m)
#pragma unroll
                    for (int n = 0; n < 2; ++n) acc[a][b][m][n] = (f32x4){0.f, 0.f, 0.f, 0.f};
        cur = nxt; cA = nA; cB = nB; ++ui;
        if constexpr (ALIGN_EPI) { if (wr == 1) PG8_BAR; }
    }
    PG8_WAIT_V(0);
    if constexpr (!ALIGN_EPI) { if (wr == 0) PG8_BAR; }
    PG8_BAR;
    if constexpr (Epi::AFTER_DRAIN) { E.fused(acc, cur, wr, wc, fr, fq, lds, wid, lane); S.done(cur); }
#undef PG8_SA
#undef PG8_SB
#undef PG8_STAGE
#undef PG8_LDA
#undef PG8_LDB
#undef PG8_MMA
#undef PG8_WAIT_V
#undef PG8_WAIT_L
#undef PG8_BAR
#undef PG8_SCHED
}
}
namespace att {
using bf16 = __hip_bfloat16;
constexpr int   D = 128, NW = 8, QBLK = 32, KVBLK = 64;
constexpr float SCALE = 0.088388347648318440f;
constexpr float THR = 8.f;
constexpr float CL2 = SCALE * 1.4426950408889634f;
constexpr float NEGBIG = -3.0e38f;
constexpr int SHM_V = KVBLK * D * 2, SHM_K = KVBLK * D * 2;
constexpr int LDS_WS = 2 * SHM_V + 2 * SHM_K, LDS_TAB = LDS_WS + NW * 64 * 4, TAB_FLOATS = 2048, LDS_ATT_END = LDS_TAB + TAB_FLOATS * 4;
using bf16x8 = __attribute__((ext_vector_type(8))) short;
using s16x4  = __attribute__((ext_vector_type(4))) short;
using f32x16 = __attribute__((ext_vector_type(16))) float;
using f32x8  = __attribute__((ext_vector_type(8))) float;
using u32x4  = __attribute__((ext_vector_type(4))) unsigned;
#define KSWZ(row, colB) ((row) * 256 + ((colB) ^ (((row) & 7) << 4)))
#define SBAR() __builtin_amdgcn_sched_barrier(0)
__device__ __forceinline__ int crow(int r, int hi) { return (r & 3) + 8 * (r >> 2) + 4 * hi; }
__device__ __forceinline__ unsigned cvtpk(float lo, float hi) {
  unsigned r; asm volatile("v_cvt_pk_bf16_f32 %0, %1, %2" : "=v"(r) : "v"(lo), "v"(hi)); return r;
}
template <typename TIn> struct Stage;
template <> struct Stage<bf16>  { using T = bf16x8;
  __device__ static __forceinline__ T ld8(const bf16* p) { return *reinterpret_cast<const bf16x8*>(p); }
  __device__ static __forceinline__ bf16x8 tobf(T x) { return x; } };
template <> struct Stage<float> { using T = f32x8;
  __device__ static __forceinline__ T ld8(const float* p) { return *reinterpret_cast<const f32x8*>(p); }
  __device__ static __forceinline__ bf16x8 tobf(T x) {
    u32x4 w = {cvtpk(x[0], x[1]), cvtpk(x[2], x[3]), cvtpk(x[4], x[5]), cvtpk(x[6], x[7])}; return *reinterpret_cast<bf16x8*>(&w); } };

__device__ __forceinline__ void partialSM(f32x16& p0, f32x16& p1, float& m_reg, float& mn, float& alpha) {
  constexpr float C = SCALE * 1.4426950408889634f;
  float pmax = p0[0]; for (int r = 1; r < 16; ++r) pmax = fmaxf(pmax, p0[r]); for (int r = 0; r < 16; ++r) pmax = fmaxf(pmax, p1[r]);
  { auto rr = __builtin_amdgcn_permlane32_swap(__float_as_uint(pmax), __float_as_uint(pmax), false, false);
    pmax = fmaxf(__uint_as_float(rr[0]), __uint_as_float(rr[1])); }
  if (__builtin_expect(__all(pmax - m_reg <= THR / SCALE), 1)) { mn = m_reg; alpha = 1.f; }
  else { mn = fmaxf(m_reg, pmax); alpha = __builtin_amdgcn_exp2f((m_reg - mn) * C); m_reg = mn; }
  float mnC = -mn * C;
  for (int r = 0; r < 16; ++r) p0[r] = fmaf(p0[r], C, mnC); for (int r = 0; r < 16; ++r) p1[r] = fmaf(p1[r], C, mnC);
  for (int r = 0; r < 16; ++r) p0[r] = __builtin_amdgcn_exp2f(p0[r]);
}
__device__ __forceinline__ void partialSM0(f32x16& p0, f32x16& p1, float& m_reg, float& alpha, const bool first) {
  constexpr float THR2 = THR * 1.4426950408889634f;
  float pmax = p0[0]; for (int r = 1; r < 16; ++r) pmax = fmaxf(pmax, p0[r]); for (int r = 0; r < 16; ++r) pmax = fmaxf(pmax, p1[r]);
  { auto rr = __builtin_amdgcn_permlane32_swap(__float_as_uint(pmax), __float_as_uint(pmax), false, false);
    pmax = fmaxf(__uint_as_float(rr[0]), __uint_as_float(rr[1])); }
  if (!first && __builtin_expect(__all(pmax <= THR2), 1)) { alpha = 1.f; }
  else { const float dl = first ? pmax : fmaxf(pmax, 0.f); m_reg += dl; alpha = first ? 1.f : __builtin_amdgcn_exp2f(-dl);
    for (int r = 0; r < 16; ++r) { p0[r] -= dl; p1[r] -= dl; } }
  for (int r = 0; r < 16; ++r) p0[r] = __builtin_amdgcn_exp2f(p0[r]);
}
__device__ __forceinline__ void finishSM(f32x16& p0, f32x16& p1, float alpha, float& l_reg, bf16x8& pa0, bf16x8& pa1, bf16x8& pa2, bf16x8& pa3) {
  for (int r = 0; r < 16; ++r) p1[r] = __builtin_amdgcn_exp2f(p1[r]);
  float ps = 0; for (int r = 0; r < 16; ++r) ps += p0[r]; for (int r = 0; r < 16; ++r) ps += p1[r];
  { auto rr = __builtin_amdgcn_permlane32_swap(__float_as_uint(ps), __float_as_uint(ps), false, false);
    ps = __uint_as_float(rr[0]) + __uint_as_float(rr[1]); }
  l_reg = l_reg * alpha + ps;
#define PK4(P, BASE, OUT) do { unsigned a0 = cvtpk(P[BASE + 0], P[BASE + 1]), a1 = cvtpk(P[BASE + 2], P[BASE + 3]);   \
    unsigned b0 = cvtpk(P[BASE + 4], P[BASE + 5]), b1 = cvtpk(P[BASE + 6], P[BASE + 7]);                              \
    auto r0 = __builtin_amdgcn_permlane32_swap(a0, b0, false, false); auto r1 = __builtin_amdgcn_permlane32_swap(a1, b1, false, false); \
    u32x4 w = {r0[0], r1[0], r0[1], r1[1]}; OUT = *reinterpret_cast<bf16x8*>(&w); } while (0)
  PK4(p0, 0, pa0); PK4(p0, 8, pa1); PK4(p1, 0, pa2); PK4(p1, 8, pa3);
#undef PK4
}
__device__ __forceinline__ void qkt(f32x16& p0, f32x16& p1, const bf16* Ks, const bf16x8* qr, int r32, int hi) {
  for (int d0 = 0; d0 < 8; ++d0) { int cb = (d0 * 16 + hi * 8) * 2;
    bf16x8 b0 = *reinterpret_cast<const bf16x8*>((const char*)Ks + KSWZ(r32, cb));
    bf16x8 b1 = *reinterpret_cast<const bf16x8*>((const char*)Ks + KSWZ(32 + r32, cb));
    p0 = __builtin_amdgcn_mfma_f32_32x32x16_bf16(b0, qr[d0], p0, 0, 0, 0);
    p1 = __builtin_amdgcn_mfma_f32_32x32x16_bf16(b1, qr[d0], p1, 0, 0, 0); }
}
__device__ __forceinline__ int v_st(int k, int c) { const int kk = (k & ~0xC) | ((k & 4) << 1) | ((k & 8) >> 1); return ((kk >> 3) * 4 + (c >> 5)) * 512 + ((kk & 7) * 32 + (c & 31)) * 2; }
__device__ __forceinline__ int v_rd_base(int lane) { return ((lane & 3) << 3) | (((lane >> 2) & 3) << 6) | (((lane >> 4) & 1) << 5) | (((lane >> 5) & 1) << 8); }
constexpr int v_rd_off(int d0, int ks, int half) { return d0 * 512 + ks * 4096 + half * 2048; }
template <int OFF> __device__ __forceinline__ s16x4 tr_read(int vb) {
  s16x4 r; asm volatile("ds_read_b64_tr_b16 %0, %1 offset:%2" : "=&v"(r) : "v"(vb), "i"(OFF) : "memory"); return r;
}
template <int D0> __device__ __forceinline__ void pv_one(f32x16& od, int vb, bf16x8 pa0, bf16x8 pa1, bf16x8 pa2, bf16x8 pa3) {
  const s16x4 l0 = tr_read<v_rd_off(D0, 0, 0)>(vb), h0 = tr_read<v_rd_off(D0, 0, 1)>(vb), l1 = tr_read<v_rd_off(D0, 1, 0)>(vb), h1 = tr_read<v_rd_off(D0, 1, 1)>(vb);
  const s16x4 l2 = tr_read<v_rd_off(D0, 2, 0)>(vb), h2 = tr_read<v_rd_off(D0, 2, 1)>(vb), l3 = tr_read<v_rd_off(D0, 3, 0)>(vb), h3 = tr_read<v_rd_off(D0, 3, 1)>(vb);
  asm volatile("s_waitcnt lgkmcnt(0)" ::: "memory"); SBAR();
#define PK(L, H) (bf16x8){L[0], L[1], L[2], L[3], H[0], H[1], H[2], H[3]}
  od = __builtin_amdgcn_mfma_f32_32x32x16_bf16(pa0, PK(l0, h0), od, 0, 0, 0);
  od = __builtin_amdgcn_mfma_f32_32x32x16_bf16(pa1, PK(l1, h1), od, 0, 0, 0);
  od = __builtin_amdgcn_mfma_f32_32x32x16_bf16(pa2, PK(l2, h2), od, 0, 0, 0);
  od = __builtin_amdgcn_mfma_f32_32x32x16_bf16(pa3, PK(l3, h3), od, 0, 0, 0);
#undef PK
}
__device__ __forceinline__ void pv_d0(f32x16* o, int vb, bf16x8 pa0, bf16x8 pa1, bf16x8 pa2, bf16x8 pa3) {
  pv_one<0>(o[0], vb, pa0, pa1, pa2, pa3); pv_one<1>(o[1], vb, pa0, pa1, pa2, pa3); pv_one<2>(o[2], vb, pa0, pa1, pa2, pa3); pv_one<3>(o[3], vb, pa0, pa1, pa2, pa3);
}
template <int KS> __device__ __forceinline__ void pv_ks(f32x16* o, int vb, bf16x8 pa) {
  const s16x4 l0 = tr_read<v_rd_off(0, KS, 0)>(vb), h0 = tr_read<v_rd_off(0, KS, 1)>(vb), l1 = tr_read<v_rd_off(1, KS, 0)>(vb), h1 = tr_read<v_rd_off(1, KS, 1)>(vb);
  const s16x4 l2 = tr_read<v_rd_off(2, KS, 0)>(vb), h2 = tr_read<v_rd_off(2, KS, 1)>(vb), l3 = tr_read<v_rd_off(3, KS, 0)>(vb), h3 = tr_read<v_rd_off(3, KS, 1)>(vb);
  asm volatile("s_waitcnt lgkmcnt(0)" ::: "memory"); SBAR();
#define PK(L, H) (bf16x8){L[0], L[1], L[2], L[3], H[0], H[1], H[2], H[3]}
  o[0] = __builtin_amdgcn_mfma_f32_32x32x16_bf16(pa, PK(l0, h0), o[0], 0, 0, 0);
  o[1] = __builtin_amdgcn_mfma_f32_32x32x16_bf16(pa, PK(l1, h1), o[1], 0, 0, 0);
  o[2] = __builtin_amdgcn_mfma_f32_32x32x16_bf16(pa, PK(l2, h2), o[2], 0, 0, 0);
  o[3] = __builtin_amdgcn_mfma_f32_32x32x16_bf16(pa, PK(l3, h3), o[3], 0, 0, 0);
#undef PK
}

__device__ __forceinline__ int t5_bucket(int rel) {
  const int base = rel > 0 ? 16 : 0; const int n = rel < 0 ? -rel : rel;
  const int v = n < 8 ? n : (n < 15 ? 8 : (n < 27 ? 9 : (n < 50 ? 10 : (n < 91 ? 11 : (n < 166 ? 12 : (n < 305 ? 13 : (n < 559 ? 14 : 15)))))));
  return base + v;
}

template <int MODE>
__device__ __forceinline__ void attn_core(const bf16* __restrict__ Qw, const bf16* __restrict__ Kh, const bf16* __restrict__ Vh, const long ldk,
                                          const int kbeg, const int NT, const int L, const int qrow, const int qw0,
                                          const float* tab, const int taboff, const float cL, const float cR,
                                          char* lds, f32x16 (&o)[4], float& l_out, float& m_out) {
  using St = Stage<bf16>;
  int tid_ = threadIdx.x; asm volatile("" : "+v"(tid_));
  const int tid = tid_, wid = __builtin_amdgcn_readfirstlane(tid >> 6), lane = tid & 63, r32 = lane & 31, hi = lane >> 5;
  bf16* V_lds = (bf16*)lds; bf16* K_lds = (bf16*)(lds + 2 * SHM_V);
  float* ws = (float*)(lds + LDS_WS) + wid * 64; float* al_l = ws + 32;
  float m_reg = (MODE == 0) ? 0.f : -1e30f, l_reg = 0; bf16x8 qr[8];
#pragma unroll
  for (int d = 0; d < 4; ++d) o[d] = f32x16{};
#pragma unroll
  for (int d0 = 0; d0 < 8; ++d0) qr[d0] = St::ld8(Qw + d0 * 16);
  const int sr = tid >> 4, sc = (tid & 15) * 8, vst0 = v_st(sr, sc), vst1 = v_st(32 + sr, sc);
  const int vb0 = (int)(uintptr_t)V_lds + v_rd_base(lane);
  struct { typename St::T vs0, vs1, ks0, ks1; } sr_[2];
#define CLAMPR(x) ((x) < 0 ? 0 : ((x) > L - 1 ? L - 1 : (x)))
#define SLOAD(i, j) do { const int k0_ = kbeg + (j) * KVBLK; const long ra_ = (long)CLAMPR(k0_ + sr) * ldk + sc, rb_ = (long)CLAMPR(k0_ + 32 + sr) * ldk + sc; \
    sr_[i].vs0 = St::ld8(Vh + ra_); sr_[i].vs1 = St::ld8(Vh + rb_); sr_[i].ks0 = St::ld8(Kh + ra_); sr_[i].ks1 = St::ld8(Kh + rb_); } while (0)
#define SWRITE(b, i) do { *(bf16x8*)((char*)V_lds + (b) * SHM_V + vst0) = St::tobf(sr_[i].vs0);          \
    *(bf16x8*)((char*)V_lds + (b) * SHM_V + vst1) = St::tobf(sr_[i].vs1); int kc = sc * 2;               \
    *(bf16x8*)((char*)K_lds + (b) * SHM_K + KSWZ(sr, kc)) = St::tobf(sr_[i].ks0);                       \
    *(bf16x8*)((char*)K_lds + (b) * SHM_K + KSWZ(32 + sr, kc)) = St::tobf(sr_[i].ks1); } while (0)
#define SWAIT() asm volatile("s_waitcnt vmcnt(4)" ::: "memory")
#define RESC(a) do { if (__any((a) < 1.f)) { if (hi == 0) al_l[r32] = (a); asm volatile("s_waitcnt lgkmcnt(0)" ::: "memory"); \
    for (int d = 0; d < 4; ++d) for (int r = 0; r < 16; ++r) o[d][r] *= al_l[crow(r, hi)]; } } while (0)
#define FILLP(P0, P1, v) do { _Pragma("unroll") for (int r = 0; r < 16; ++r) { P0[r] = (v); P1[r] = (v); } } while (0)
#define LOOKP(P0, P1, k0_) do { const float* tp_ = tab + ((k0_) - qrow + taboff + 4 * hi); \
    _Pragma("unroll") for (int r = 0; r < 16; ++r) { P0[r] = tp_[(r & 3) + 8 * (r >> 2)]; P1[r] = tp_[32 + (r & 3) + 8 * (r >> 2)]; } } while (0)
#ifdef EXP_SIMPLEINIT
#define INIT0(P0, P1, k0_) FILLP(P0, P1, cL)
#else
#define INIT0(P0, P1, k0_) do { if (k0_ + 63 - qw0 <= -559 || k0_ - qw0 - 31 >= 559) { const float cc_ = ((k0_ < qw0) ? cL : cR) - m_reg; FILLP(P0, P1, cc_); } \
    else { LOOKP(P0, P1, k0_); _Pragma("unroll") for (int r = 0; r < 16; ++r) { P0[r] -= m_reg; P1[r] -= m_reg; } } } while (0)
#endif
#define PSM(P0, P1, mn_, al_, first_) do { if (MODE == 0) partialSM0(P0, P1, m_reg, al_, first_); else partialSM(P0, P1, m_reg, mn_, al_); } while (0)
#define INITP(P0, P1, j) do { const int k0_ = kbeg + (j) * KVBLK; \
    if (MODE == 0) { INIT0(P0, P1, k0_); } \
    else { if (k0_ < 0 || k0_ >= L || k0_ - qw0 - 31 > 64 || k0_ + 63 - qw0 < -64) { FILLP(P0, P1, NEGBIG); live_ = false; } else LOOKP(P0, P1, k0_); } } while (0)
  f32x16 pA0, pA1, pB0, pB1; float mnA, mnB, alA, alB; bf16x8 pa0, pa1, pa2, pa3;
  constexpr int SE = 0, SO = 1;
  SLOAD(SE, 0); asm volatile("s_waitcnt vmcnt(0)" ::: "memory"); SWRITE(0, SE); __syncthreads();
  bool live_ = true; INITP(pA0, pA1, 0); if (MODE == 0 || live_) qkt(pA0, pA1, K_lds, qr, r32, hi); PSM(pA0, pA1, mnA, alA, true);
  SLOAD(SO, 1); if (2 < NT) SLOAD(SE, 2);
  SWAIT(); SWRITE(1, SO); __syncthreads();
  for (int j = 1; j + 1 < NT; j += 2) {
    SBAR(); live_ = true; INITP(pB0, pB1, j);
    SBAR(); if (MODE == 0 || live_) qkt(pB0, pB1, (bf16*)((char*)K_lds + SHM_K), qr, r32, hi);
    finishSM(pA0, pA1, alA, l_reg, pa0, pa1, pa2, pa3); SBAR();
    SLOAD(SO, j + 2); SBAR();
    pv_d0(o, vb0, pa0, pa1, pa2, pa3); PSM(pB0, pB1, mnB, alB, false);
    __syncthreads(); SWAIT(); SWRITE(0, SE);
    RESC(alB); __syncthreads();
    SBAR(); live_ = true; INITP(pA0, pA1, j + 1);
    SBAR(); if (MODE == 0 || live_) qkt(pA0, pA1, K_lds, qr, r32, hi);
    finishSM(pB0, pB1, alB, l_reg, pa0, pa1, pa2, pa3); SBAR();
    if (j + 3 < NT) SLOAD(SE, j + 3); SBAR();
    pv_d0(o, vb0 + (int)SHM_V, pa0, pa1, pa2, pa3); PSM(pA0, pA1, mnA, alA, false);
    __syncthreads(); SWAIT(); SWRITE(1, SO);
    RESC(alA); __syncthreads();
  }
  SBAR(); live_ = true; INITP(pB0, pB1, NT - 1);
  SBAR(); if (MODE == 0 || live_) qkt(pB0, pB1, (bf16*)((char*)K_lds + SHM_K), qr, r32, hi);
  finishSM(pA0, pA1, alA, l_reg, pa0, pa1, pa2, pa3); SBAR();
  pv_d0(o, vb0, pa0, pa1, pa2, pa3); PSM(pB0, pB1, mnB, alB, false);
  __syncthreads(); RESC(alB);
  finishSM(pB0, pB1, alB, l_reg, pa0, pa1, pa2, pa3); SBAR();
  pv_d0(o, vb0 + (int)SHM_V, pa0, pa1, pa2, pa3);
  l_out = l_reg; m_out = m_reg;
#undef CLAMPR
#undef SLOAD
#undef SWRITE
#undef SWAIT
#undef RESC
#undef FILLP
#undef LOOKP
#undef INITP
#undef PSM
#undef INIT0
}
}
namespace att3 {
using namespace att;
constexpr int VBUF = 32768, KBUF = 16384;
constexpr int L_V = 0, L_K = 2 * VBUF, L_XM = L_K + 2 * KBUF, L_XP = L_XM + 2048, L_WS = L_XP + 32768, L_TAB = L_WS + 2048, L_END = L_TAB + 8192;
__device__ __forceinline__ void attn_core3(const bf16* __restrict__ Qw, const bf16* __restrict__ Kh, const bf16* __restrict__ Vh, const long ldk, const int NT,
                                           const int qrow, const int qw0, const float* tab, const float cL, const float cR, char* lds, f32x16 (&o)[4], float& l_out) {
  using St = Stage<bf16>;
  constexpr float THR2 = THR * 1.4426950408889634f;
  int tid_ = threadIdx.x; asm volatile("" : "+v"(tid_));
  const int tid = tid_, wid = __builtin_amdgcn_readfirstlane(tid >> 6), lane = tid & 63, r32 = lane & 31, hi = lane >> 5, vh = wid & 1;
  char* V_lds = lds + L_V; char* K_lds = lds + L_K;
  float* xm = (float*)(lds + L_XM); char* xp = lds + L_XP;
  float* al_l = (float*)(lds + L_WS) + wid * 64;
  float m_reg = 0.f, l_reg = 0.f, pm_own; bf16x8 qr[8];
#pragma unroll
  for (int d = 0; d < 4; ++d) o[d] = f32x16{};
#pragma unroll
  for (int d0 = 0; d0 < 8; ++d0) qr[d0] = St::ld8(Qw + d0 * 16);
  const int vb0 = (int)(uintptr_t)V_lds + vh * 16384 + v_rd_base(lane);
  typedef __attribute__((address_space(3))) unsigned lds_u32; typedef __attribute__((address_space(3))) char lds_c;
  lds_c* const kdst = (lds_c*)K_lds + wid * 1024; lds_c* const vdst = (lds_c*)V_lds + wid * 1024;
  const int r8_ = (lane >> 2) & 7;
  const unsigned lk_off = (unsigned)(((lane >> 4) * (int)ldk + (((lane & 15) ^ ((wid * 4 + (lane >> 4)) & 7)) * 8)) * 2);
  const unsigned lv_off = (unsigned)((((r8_ & 3) + 8 * (r8_ >> 2)) * (int)ldk + 32 * (lane >> 5) + 8 * (lane & 3)) * 2);
#define DMA_K(t, kbuf) do { _Pragma("unroll") for (int i = 0; i < 2; ++i) { const char* sb_ = (const char*)Kh + ((long)((t) * KVBLK + wid * 4 + 32 * i) * ldk) * 2; \
      __builtin_amdgcn_global_load_lds((const unsigned*)(sb_ + lk_off), (lds_u32*)(kdst + (kbuf) * KBUF + i * 8192), 16, 0, 0); } } while (0)
#define DMA_V(t, vbuf) do { _Pragma("unroll") for (int i = 0; i < 4; ++i) { const int S_ = (wid >> 1) + 4 * (i & 1); \
      const char* sb_ = (const char*)Vh + ((long)((t) * KVBLK + 16 * (S_ >> 1) + 4 * (S_ & 1)) * ldk + (i >> 1) * 128 + 64 * (wid & 1)) * 2; \
      __builtin_amdgcn_global_load_lds((const unsigned*)(sb_ + lv_off), (lds_u32*)(vdst + (vbuf) * VBUF + i * 8192), 16, 0, 0); } } while (0)
#define WAITBAR() asm volatile("s_waitcnt vmcnt(0) lgkmcnt(0)\n\ts_barrier" ::: "memory")
#define INIT3(P, t) do { const int k0_ = (t) * KVBLK + 32 * vh; \
    if (k0_ + 31 - qw0 <= -559 || k0_ - qw0 - 31 >= 559) { const float cc_ = ((k0_ < qw0) ? cL : cR) - m_reg; _Pragma("unroll") for (int r = 0; r < 16; ++r) P[r] = cc_; } \
    else { const float* tp_ = tab + (k0_ - qrow + 1024 + 4 * hi); _Pragma("unroll") for (int r = 0; r < 16; ++r) P[r] = tp_[(r & 3) + 8 * (r >> 2)] - m_reg; } } while (0)
#define ROWMAX3(P, xbuf) do { float pmx = P[0]; _Pragma("unroll") for (int r = 1; r < 16; ++r) pmx = fmaxf(pmx, P[r]); \
    auto rr = __builtin_amdgcn_permlane32_swap(__float_as_uint(pmx), __float_as_uint(pmx), false, false); pm_own = fmaxf(__uint_as_float(rr[0]), __uint_as_float(rr[1])); \
    if (hi == 0) xm[(xbuf) * 256 + wid * 32 + r32] = pm_own; } while (0)
#define PACK3(P, B, OUT) do { unsigned a0 = cvtpk(P[B + 0], P[B + 1]), a1 = cvtpk(P[B + 2], P[B + 3]), b0 = cvtpk(P[B + 4], P[B + 5]), b1 = cvtpk(P[B + 6], P[B + 7]); \
    auto r0 = __builtin_amdgcn_permlane32_swap(a0, b0, false, false); auto r1 = __builtin_amdgcn_permlane32_swap(a1, b1, false, false); \
    u32x4 w = {r0[0], r1[0], r0[1], r1[1]}; OUT = *reinterpret_cast<bf16x8*>(&w); } while (0)
#define STAGE3(j, PC, PN, EV, FIRST_, LAST_) do { \
    if (!(LAST_) && (j) + 2 < NT) DMA_K((j) + 2, (EV) ? 0 : 1); \
    DMA_V((j), (EV) ? 0 : 1); \
    bf16x8 qX, qY; if (!(FIRST_)) { qX = *(const bf16x8*)(xp + ((EV) ? 1 : 0) * 16384 + (wid ^ 1) * 2048 + lane * 32); qY = *(const bf16x8*)(xp + ((EV) ? 1 : 0) * 16384 + (wid ^ 1) * 2048 + lane * 32 + 16); } \
    const float pmx_ = fmaxf(pm_own, xm[((EV) ? 0 : 1) * 256 + (wid ^ 1) * 32 + r32]); float alpha = 1.f; \
    if (FIRST_) { m_reg = pmx_; _Pragma("unroll") for (int r = 0; r < 16; ++r) PC[r] -= pmx_; } \
    else if (!__builtin_expect(__all(pmx_ <= THR2), 1)) { const float dl = fmaxf(pmx_, 0.f); m_reg += dl; alpha = __builtin_amdgcn_exp2f(-dl); _Pragma("unroll") for (int r = 0; r < 16; ++r) PC[r] -= dl; } \
    if (!(LAST_)) { INIT3(PN, (j) + 1); \
      const char* kb_ = K_lds + ((EV) ? 1 : 0) * KBUF; \
      _Pragma("unroll") for (int d0 = 0; d0 < 8; ++d0) { const int cb = (d0 * 16 + hi * 8) * 2; \
        const bf16x8 bk = *reinterpret_cast<const bf16x8*>(kb_ + KSWZ(32 * vh + r32, cb)); PN = __builtin_amdgcn_mfma_f32_32x32x16_bf16(bk, qr[d0], PN, 0, 0, 0); \
        PC[2 * d0] = __builtin_amdgcn_exp2f(PC[2 * d0]); PC[2 * d0 + 1] = __builtin_amdgcn_exp2f(PC[2 * d0 + 1]); } } \
    else { _Pragma("unroll") for (int r = 0; r < 16; ++r) PC[r] = __builtin_amdgcn_exp2f(PC[r]); } \
    { bf16x8 a0_, a1_, a2_, a3_; const int vbb_ = vb0 + ((EV) ? 1 : 0) * VBUF; \
      if (!(FIRST_)) { a0_ = vh ? qX : paX; a1_ = vh ? qY : paY; a2_ = vh ? paX : qX; a3_ = vh ? paY : qY; pv_ks<0>(o, vbb_, a0_); } \
      if (!(LAST_)) ROWMAX3(PN, (EV) ? 1 : 0); \
      if (!(FIRST_)) pv_ks<1>(o, vbb_, a1_); \
      { float ps = 0.f; _Pragma("unroll") for (int r = 0; r < 16; ++r) ps += PC[r]; \
        auto rr = __builtin_amdgcn_permlane32_swap(__float_as_uint(ps), __float_as_uint(ps), false, false); ps = __uint_as_float(rr[0]) + __uint_as_float(rr[1]); l_reg = l_reg * alpha + ps; } \
      if (!(FIRST_)) pv_ks<2>(o, vbb_, a2_); \
      PACK3(PC, 0, paX); \
      if (!(FIRST_)) pv_ks<3>(o, vbb_, a3_); \
      PACK3(PC, 8, paY); \
      *(bf16x8*)(xp + ((EV) ? 0 : 1) * 16384 + wid * 2048 + lane * 32) = paX; *(bf16x8*)(xp + ((EV) ? 0 : 1) * 16384 + wid * 2048 + lane * 32 + 16) = paY; } \
    if (__any(alpha < 1.f)) { if (hi == 0) al_l[r32] = alpha; asm volatile("s_waitcnt lgkmcnt(0)" ::: "memory"); \
      _Pragma("unroll") for (int d = 0; d < 4; ++d) _Pragma("unroll") for (int r = 0; r < 16; ++r) o[d][r] *= al_l[crow(r, hi)]; } \
    WAITBAR(); \
  } while (0)
  f32x16 pA, pB; bf16x8 paX, paY;
  DMA_K(0, 0); DMA_K(1, 1); WAITBAR();
  INIT3(pA, 0);
  { const char* kb_ = K_lds;
#pragma unroll
    for (int d0 = 0; d0 < 8; ++d0) { const int cb = (d0 * 16 + hi * 8) * 2; const bf16x8 bk = *reinterpret_cast<const bf16x8*>(kb_ + KSWZ(32 * vh + r32, cb)); pA = __builtin_amdgcn_mfma_f32_32x32x16_bf16(bk, qr[d0], pA, 0, 0, 0); } }
  ROWMAX3(pA, 0);
  WAITBAR();
  STAGE3(0, pA, pB, true, true, false);
#pragma unroll 1
  for (int j = 1; j < NT - 1; j += 2) {
    STAGE3(j, pB, pA, false, false, false);
    STAGE3(j + 1, pA, pB, true, false, false);
  }
  STAGE3(NT - 1, pB, pA, false, false, true);
  { const bf16x8 qX = *(const bf16x8*)(xp + 16384 + (wid ^ 1) * 2048 + lane * 32), qY = *(const bf16x8*)(xp + 16384 + (wid ^ 1) * 2048 + lane * 32 + 16);
    const bf16x8 a0_ = vh ? qX : paX, a1_ = vh ? qY : paY, a2_ = vh ? paX : qX, a3_ = vh ? paY : qY; pv_d0(o, vb0 + VBUF, a0_, a1_, a2_, a3_); }
  asm volatile("s_waitcnt lgkmcnt(0)\n\ts_barrier" ::: "memory");
  l_out = l_reg;
#undef DMA_K
#undef DMA_V
#undef WAITBAR
#undef INIT3
#undef ROWMAX3
#undef PACK3
#undef STAGE3
}
}

constexpr int SEQ = 8192, DM = 2048, DFF = 8192, NLAYER = 4;
constexpr int EV_QKV = 4608, EV_N = 5632  , OD_N = 6144;
constexpr float NORM_EPS = 1e-6f;
constexpr size_t MiB = 1u << 20;
constexpr size_t WS_WIN_E = 0;
constexpr size_t WS_WOUT = 44 * MiB;
constexpr size_t WS_WQKV_O = 76 * MiB;
constexpr size_t WS_WFF1 = 124 * MiB;
constexpr size_t WS_WFF2 = 252 * MiB;
constexpr size_t WS_DFT = 380 * MiB;
constexpr size_t WS_HPM = 508 * MiB;
constexpr size_t WS_H = 636 * MiB;
constexpr size_t WS_CAT = 668 * MiB;
constexpr size_t WS_WCS = 700 * MiB;
constexpr size_t WS_R = 701 * MiB;
constexpr size_t WS_HID = WS_R;
constexpr size_t WS_PROJ = WS_R;
constexpr size_t WS_YT = WS_R + 72 * MiB;
constexpr size_t WS_T = WS_R + 96 * MiB;
constexpr size_t WS_OB = WS_R + 88 * MiB;
constexpr size_t WS_LSE = WS_R + 160 * MiB;
constexpr size_t WS_PART = WS_R + 162 * MiB;
constexpr size_t WS_END = WS_R + 226 * MiB;
constexpr size_t WS_CTL = WS_END;
constexpr size_t WS_DTAB = WS_END + 16384;
constexpr size_t WS_TOTAL = WS_END + 1 * MiB;
constexpr int LDS_BYTES = 147456;
constexpr int XB_LDS_OFF = 147392;

typedef unsigned short bf16r;
typedef unsigned v4u __attribute__((ext_vector_type(4)));
typedef unsigned v2u __attribute__((ext_vector_type(2)));
typedef float f32x4 __attribute__((ext_vector_type(4)));
#define LAS __attribute__((address_space(3)))
__device__ __forceinline__ unsigned f2bf(float f) { unsigned u = __builtin_bit_cast(unsigned, f); return (u + 0x7fffu + ((u >> 16) & 1u)) >> 16; }
__device__ __forceinline__ unsigned pk2(float lo, float hi) { return f2bf(lo) | (f2bf(hi) << 16); }
__device__ __forceinline__ float bf2f(unsigned short b) { return __builtin_bit_cast(float, (unsigned)b << 16); }
__device__ __forceinline__ float wave_sum(float v) {
#pragma unroll
    for (int o = 1; o < 64; o <<= 1) v += __shfl_xor(v, o);
    return v;
}

struct Args { const float* in[17]; float* out; unsigned char* ws; };

struct TJob { int in_idx; int K; int ldw; int ncols; long src_off; long dst_off; int items_end; int qcols; };
#define TJ_ITEMS(K, nc) (((K) / 64) * ((nc) / 32))
__device__ const TJob g_jobs[18] = {
    {5, 2048, 5120, 4608, 0L,                   (long)(WS_WIN_E),              4608, 0},
    {5, 2048, 5120, 4608, 2048L * 5120,         (long)(WS_WIN_E + 22 * MiB),   9216, 0},
    {7, 2048, 2048, 2048, 0L,                   (long)(WS_WOUT),               11264, 0},
    {14, 2048, 2048, 2048, 0L,                  (long)(WS_WOUT + 8 * MiB),     13312, 0},
    {7, 2048, 2048, 2048, 2048L * 2048,         (long)(WS_WOUT + 16 * MiB),    15360, 0},
    {14, 2048, 2048, 2048, 2048L * 2048,        (long)(WS_WOUT + 24 * MiB),    17408, 0},
    {8, 2048, 6144, 6144, 0L,                   (long)(WS_WQKV_O),             23552, 2048},
    {8, 2048, 6144, 6144, 2048L * 6144,         (long)(WS_WQKV_O + 24 * MiB),  29696, 2048},
    {15, 2048, 8192, 8192, 0L,                  (long)(WS_WFF1),               37888, 0},
    {15, 2048, 8192, 8192, 1L * 2048 * 8192,    (long)(WS_WFF1 + 32 * MiB),    46080, 0},
    {15, 2048, 8192, 8192, 2L * 2048 * 8192,    (long)(WS_WFF1 + 64 * MiB),    54272, 0},
    {15, 2048, 8192, 8192, 3L * 2048 * 8192,    (long)(WS_WFF1 + 96 * MiB),    62464, 0},
    {16, 8192, 2048, 2048, 0L,                  (long)(WS_WFF2),               70656, 0},
    {16, 8192, 2048, 2048, 1L * 2048 * 8192,    (long)(WS_WFF2 + 32 * MiB),    78848, 0},
    {16, 8192, 2048, 2048, 2L * 2048 * 8192,    (long)(WS_WFF2 + 64 * MiB),    87040, 0},
    {16, 8192, 2048, 2048, 3L * 2048 * 8192,    (long)(WS_WFF2 + 96 * MiB),    95232, 0},
    {0, 0, 0, 0, 0L, 0L, 95232, 0}, {0, 0, 0, 0, 0L, 0L, 95232, 0}};
constexpr int TJ_TOTAL = 95232, TJ_NJOBS = 16;

__device__ __forceinline__ void transpose_item(const float* W, int ldw, int K, int ncols, bf16r* WT, LAS float* scr, int item, int lane, int qcols) {
    const int nblk = ncols / 32, kb = item / nblk, nb = item % nblk, k0 = 64 * kb, n0 = 32 * nb;
    float tv[32];
#pragma unroll
    for (int i = 0; i < 32; ++i) { const int kk = 2 * i + (lane >> 5); tv[i] = W[(size_t)(k0 + kk) * ldw + n0 + (lane & 31)]; }
    const float wsc = (n0 < qcols) ? att::CL2 : 1.f;
#pragma unroll
    for (int i = 0; i < 32; ++i) { const int kk = 2 * i + (lane >> 5); scr[kk * 33 + (lane & 31)] = tv[i] * wsc; }
    asm volatile("s_waitcnt lgkmcnt(0)" ::: "memory");
    const int c = lane & 7;
#pragma unroll
    for (int j = 0; j < 4; ++j) { const int n = (lane >> 3) + 8 * j; const LAS float* s = scr + (8 * c) * 33 + n;
        v4u o; o.x = pk2(s[0 * 33], s[1 * 33]); o.y = pk2(s[2 * 33], s[3 * 33]); o.z = pk2(s[4 * 33], s[5 * 33]); o.w = pk2(s[6 * 33], s[7 * 33]);
        *(v4u*)(WT + (size_t)(n0 + n) * K + k0 + 8 * c) = o; }
    asm volatile("s_waitcnt lgkmcnt(0)" ::: "memory");
}

template <bool OUTF32>
__device__ __forceinline__ void rms_row(const float* xrow, const float* g, void* orow, int lane) {
    const f32x4* xr = (const f32x4*)xrow + lane; const f32x4* gr = (const f32x4*)g + lane;
    f32x4 v[8]; float s = 0.f;
#pragma unroll
    for (int j = 0; j < 8; ++j) { v[j] = xr[64 * j]; s += (v[j].x * v[j].x + v[j].y * v[j].y) + (v[j].z * v[j].z + v[j].w * v[j].w); }
    const float rstd = 1.f / sqrtf(wave_sum(s) * (1.f / DM) + NORM_EPS);
#pragma unroll
    for (int j = 0; j < 8; ++j) { const f32x4 gg = gr[64 * j]; const f32x4 y = v[j] * rstd * gg;
        if (OUTF32) ((f32x4*)orow)[lane + 64 * j] = y;
        else { v2u w; w.x = pk2(y.x, y.y); w.y = pk2(y.z, y.w); ((v2u*)orow)[lane + 64 * j] = w; } }
}
__device__ __forceinline__ void rms_pair_row(const float* x, const float* g, bf16r* Hh, bf16r* HPM, int t, int lane) {
    const f32x4* xa = (const f32x4*)(x + (size_t)t * DM) + lane; const f32x4* xb = (const f32x4*)(x + (size_t)(t + 4096) * DM) + lane; const f32x4* gr = (const f32x4*)g + lane;
    f32x4 a[8], b[8]; float sa = 0.f, sb = 0.f;
#pragma unroll
    for (int j = 0; j < 8; ++j) { a[j] = xa[64 * j]; b[j] = xb[64 * j]; sa += (a[j].x * a[j].x + a[j].y * a[j].y) + (a[j].z * a[j].z + a[j].w * a[j].w); sb += (b[j].x * b[j].x + b[j].y * b[j].y) + (b[j].z * b[j].z + b[j].w * b[j].w); }
    const float ra = 1.f / sqrtf(wave_sum(sa) * (1.f / DM) + NORM_EPS), rb = 1.f / sqrtf(wave_sum(sb) * (1.f / DM) + NORM_EPS);
#pragma unroll
    for (int j = 0; j < 8; ++j) { const f32x4 gg = gr[64 * j]; const f32x4 ya = a[j] * ra * gg, yb = b[j] * rb * gg, yp = ya + yb, ym = ya - yb; v2u w;
        w.x = pk2(ya.x, ya.y); w.y = pk2(ya.z, ya.w); ((v2u*)(Hh + (size_t)t * DM))[lane + 64 * j] = w;
        w.x = pk2(yb.x, yb.y); w.y = pk2(yb.z, yb.w); ((v2u*)(Hh + (size_t)(t + 4096) * DM))[lane + 64 * j] = w;
        w.x = pk2(yp.x, yp.y); w.y = pk2(yp.z, yp.w); ((v2u*)(HPM + (size_t)t * DM))[lane + 64 * j] = w;
        w.x = pk2(ym.x, ym.y); w.y = pk2(ym.z, ym.w); ((v2u*)(HPM + (size_t)(t + 4096) * DM))[lane + 64 * j] = w; }
}
__device__ __forceinline__ void rms_pair_phase(const float* x, const float* g, bf16r* Hh, bf16r* HPM, int gw, int NGW, int lane) {
    asm volatile("" : "+v"(lane));
#pragma unroll 2
    for (int t = gw; t < SEQ / 2; t += NGW) rms_pair_row(x, g, Hh, HPM, t, lane);
}
template <bool OUTF32>
__device__ __forceinline__ void rms_phase(const float* x, const float* g, void* out, int gw, int NGW, int lane) {
    asm volatile("" : "+v"(lane));
#pragma unroll 2
    for (int m = gw; m < SEQ; m += NGW) rms_row<OUTF32>(x + (size_t)m * DM, g, OUTF32 ? (void*)((float*)out + (size_t)m * DM) : (void*)((bf16r*)out + (size_t)m * DM), lane);
}

__device__ __forceinline__ void diff_attn_unit(int h, int c, int qb, const att::bf16* PROJ, float* T, const float* table, char* lds, bool build_tab) {
    using namespace att3;
    int tid_ = threadIdx.x; asm volatile("" : "+v"(tid_));
    const int tid = tid_, wid = __builtin_amdgcn_readfirstlane(tid >> 6), lane = tid & 63, r32 = lane & 31, hi = lane >> 5, g = wid >> 1;
    float* tab = (float*)(lds + L_TAB);
    constexpr float LOG2E = 1.4426950408889634f;
    __syncthreads();
    if (build_tab) for (int i = tid; i < 2048; i += 512) tab[i] = table[t5_bucket(i - 1024) * 20 + 12 + h] * LOG2E;
    const float cL = table[15 * 20 + 12 + h] * LOG2E, cR = table[31 * 20 + 12 + h] * LOG2E;
    __syncthreads();
    const int q0 = qb * 128, qw0 = q0 + g * 32, qrow = qw0 + r32;
    const bf16* Qw = PROJ + (size_t)qrow * OD_N + h * 256 + c * 128 + hi * 8;
    const bf16* Kh = PROJ + 2048 + h * 256 + c * 128;
    const bf16* Vh = PROJ + 4096 + h * 256;
    f32x16 o[4]; float l;
    attn_core3(Qw, Kh, Vh, (long)OD_N, SEQ / 64, qrow, qw0, tab, cL, cR, lds, o, l);
    {
        int t2 = threadIdx.x; asm volatile("" : "+v"(t2));
        const int wid2 = __builtin_amdgcn_readfirstlane(t2 >> 6), lane2 = t2 & 63, r2 = lane2 & 31, hi2 = lane2 >> 5;
        float* xm = (float*)(lds + L_XM); float* li_l = (float*)(lds + L_WS) + wid2 * 64;
        if (hi2 == 0) xm[wid2 * 32 + r2] = l;
        __syncthreads();
        if (hi2 == 0) li_l[r2] = l + xm[(wid2 ^ 1) * 32 + r2];
        asm volatile("s_waitcnt lgkmcnt(0)" ::: "memory");
        float* Tw = T + (size_t)c * SEQ * DM + (size_t)(qb * 128 + (wid2 >> 1) * 32 + 4 * hi2) * DM + h * 256 + (wid2 & 1) * 128 + r2;
#pragma unroll
        for (int r = 0; r < 16; ++r) { const float rl = __builtin_amdgcn_rcpf(li_l[crow(r, hi2)]); float* Tr = Tw + (size_t)((r & 3) + 8 * (r >> 2)) * DM;
#pragma unroll
            for (int d0 = 0; d0 < 4; ++d0) Tr[d0 * 32] = o[d0][r] * rl; }
        __syncthreads();
    }
}
__device__ __forceinline__ void diff_post_row(const float* T, bf16r* CAT, const float* subg, float lam, float post, int m, int lane) {
    const f32x4* t0 = (const f32x4*)(T + (size_t)m * DM) + lane; const f32x4* t1 = (const f32x4*)(T + (size_t)SEQ * DM + (size_t)m * DM) + lane;
#pragma unroll
    for (int hh = 0; hh < 8; ++hh) {
        const f32x4 a = t0[64 * hh], b = t1[64 * hh]; const f32x4 d = a - b * lam;
        const float ss = wave_sum((d.x * d.x + d.y * d.y) + (d.z * d.z + d.w * d.w));
        const float sc = post / sqrtf(ss * (1.f / 256.f) + NORM_EPS);
        const f32x4 gg = *((const f32x4*)subg + lane); const f32x4 y = d * sc * gg;
        v2u w; w.x = pk2(y.x, y.y); w.y = pk2(y.z, y.w); *((v2u*)(CAT + (size_t)m * DM + 256 * hh) + lane) = w;
    }
}

__device__ __forceinline__ void diff_post_block(const float* T, bf16r* CAT, const float* subg, float lam, float post, int h, int qb) {
    int t_ = threadIdx.x; asm volatile("" : "+v"(t_));
    const int wid = __builtin_amdgcn_readfirstlane(t_ >> 6), lane = t_ & 63;
    asm volatile("s_waitcnt vmcnt(0)" ::: "memory"); __syncthreads();
    const f32x4 gg = *((const f32x4*)subg + lane);
    const float* t0 = T + ((size_t)qb * 128 + wid * 16) * DM + h * 256 + 4 * lane; const float* t1 = t0 + (size_t)SEQ * DM;
    bf16r* cw = CAT + ((size_t)qb * 128 + wid * 16) * DM + h * 256 + 4 * lane;
#pragma unroll 4
    for (int i = 0; i < 16; ++i) {
        const f32x4 a = *(const f32x4*)(t0 + (size_t)i * DM), b = *(const f32x4*)(t1 + (size_t)i * DM); const f32x4 d = a - b * lam;
        const float ss = wave_sum((d.x * d.x + d.y * d.y) + (d.z * d.z + d.w * d.w));
        const float sc = post / sqrtf(ss * (1.f / 256.f) + NORM_EPS); const f32x4 y = d * sc * gg;
        v2u w; w.x = pk2(y.x, y.y); w.y = pk2(y.z, y.w); *(v2u*)(cw + (size_t)i * DM) = w;
    }
}

__device__ __forceinline__ void dil_attn_unit(int head, int br, int cls, int qb, const att::bf16* QKV, bf16r* OB, float* LSE, const float* table, char* lds) {
    using namespace att;
    int tid_ = threadIdx.x; asm volatile("" : "+v"(tid_));
    const int tid = tid_, wid = __builtin_amdgcn_readfirstlane(tid >> 6), lane = tid & 63, r32 = lane & 31, hi = lane >> 5;
    const int dil = br == 0 ? 1 : (br == 1 ? 4 : 16), L = SEQ / dil;
    float* tab = (float*)(lds + LDS_TAB);
    __syncthreads();
    for (int i = tid; i < 640; i += 512) tab[i] = table[(br * 12 + head) * 640 + i];
    __syncthreads();
    const int q0 = qb * 256, qw0 = q0 + wid * 32, qrow = qw0 + r32;
    const bf16* Qw = QKV + ((size_t)qrow * dil + cls) * EV_QKV + head * 128 + hi * 8;
    const bf16* Kh = QKV + (size_t)cls * EV_QKV + 1536 + head * 128;
    const bf16* Vh = QKV + (size_t)cls * EV_QKV + 3072 + head * 128;
    f32x16 o[4]; float l, m;
    attn_core<1>(Qw, Kh, Vh, (long)EV_QKV * dil, q0 - 64, 6, L, qrow, qw0, tab, 320, 0.f, 0.f, lds, o, l, m);
    float* li_l = (float*)(lds + LDS_WS) + wid * 64;
    if (hi == 0) { li_l[r32] = l; LSE[((size_t)br * SEQ + (size_t)qrow * dil + cls) * 12 + head] = m * CL2 + log2f(l); }
    asm volatile("s_waitcnt lgkmcnt(0)" ::: "memory");
    bf16r* Ow = OB + (size_t)br * SEQ * 1536 + head * 128 + r32;
#pragma unroll
    for (int r = 0; r < 16; ++r) { const int orow = crow(r, hi); const float rl = __builtin_amdgcn_rcpf(li_l[orow]); const size_t pos = (size_t)(qw0 + orow) * dil + cls;
#pragma unroll
        for (int d0 = 0; d0 < 4; ++d0) Ow[pos * 1536 + d0 * 32] = (bf16r)f2bf(o[d0][r] * rl); }
    __syncthreads();
}
#define XB_TMO      128
#define XB_XCNT(j)  (256  + 64 * (j))
#define XB_XSUB(j)  (1280 + 64 * (j))
#define XB_XGEN(j)  (2304 + 64 * (j))
#define XB_TOP      3328
#define XB_TOPGEN   3392
#define XCD_BAR_WORDS 3456
#define XB_SPIN_CAP (1u << 22)

__device__ __forceinline__ unsigned xb_ld(unsigned* p)              { return __hip_atomic_load(p, __ATOMIC_RELAXED, __HIP_MEMORY_SCOPE_AGENT); }
__device__ __forceinline__ unsigned xb_add(unsigned* p, unsigned v) { return __hip_atomic_fetch_add(p, v, __ATOMIC_RELAXED, __HIP_MEMORY_SCOPE_AGENT); }
__device__ __forceinline__ unsigned xb_xcc_id() { return (unsigned)__builtin_amdgcn_s_getreg((3 << 11) | 20) & 0xFu; }
#define XB_SPIN(cond, bar) do { unsigned _sp = 0; while (cond) { __builtin_amdgcn_s_sleep(1); \
    if ((++_sp & 255u) == 0u) { if (xb_ld(&(bar)[XB_TMO])) break; if (_sp > XB_SPIN_CAP) { atomicAdd(&(bar)[XB_TMO], 1u); break; } } } } while (0)

struct XcdBarrier {
    unsigned* bar; unsigned x;
    volatile LAS unsigned* st;
};

__device__ __forceinline__ XcdBarrier xcd_barrier_post(unsigned* bar, volatile LAS unsigned* st) {
    XcdBarrier b; b.bar = bar; b.x = xb_xcc_id(); b.st = st;
    if (threadIdx.x == 0) (void)xb_add(&bar[XB_XCNT(b.x)], 1u);
    return b;
}
__device__ __forceinline__ void xcd_barrier_complete(unsigned* bar, unsigned x, unsigned& nloc, unsigned& nx) {
    const unsigned G = gridDim.x * gridDim.y * gridDim.z;
    unsigned sum, cnt, mine, sp = 0u;
    for (;;) {
        sum = 0u; cnt = 0u; mine = 0u;
#pragma unroll
        for (unsigned j = 0; j < 16; ++j) { const unsigned c = xb_ld(&bar[XB_XCNT(j)]); sum += c; cnt += (c > 0u) ? 1u : 0u; mine = (j == x) ? c : mine; }
        if (sum == G) break;
        __builtin_amdgcn_s_sleep(1);
        if ((++sp & 255u) == 0u) { if (xb_ld(&bar[XB_TMO])) break; if (sp > XB_SPIN_CAP) { atomicAdd(&bar[XB_TMO], 1u); break; } }
    }
    nloc = mine > 0u ? mine : 1u; nx = cnt > 0u ? cnt : 1u;
}

__device__ __forceinline__ void xcd_barrier(const XcdBarrier& b) {
    asm volatile("s_waitcnt vmcnt(0)" ::: "memory");
    __syncthreads();
    if (threadIdx.x == 0) {
        unsigned* bar = b.bar;
        __builtin_amdgcn_s_waitcnt(0);
        unsigned nloc = b.st[0], nx = b.st[1];
        if (nloc == 0u) { xcd_barrier_complete(bar, b.x, nloc, nx); b.st[0] = nloc; b.st[1] = nx; }
        const unsigned old = xb_add(&bar[XB_XSUB(b.x)], 1u);
        const unsigned gen = old / nloc;
        if (old + 1u == (gen + 1u) * nloc) {
            __builtin_amdgcn_fence(__ATOMIC_RELEASE, "agent");
            asm volatile("s_waitcnt vmcnt(0)" ::: "memory");
            const unsigned og = xb_add(&bar[XB_TOP], 1u);
            const unsigned tg = og / nx;
            if (og + 1u == (tg + 1u) * nx) xb_add(&bar[XB_TOPGEN], 1u);
            else XB_SPIN(xb_ld(&bar[XB_TOPGEN]) == tg, bar);
            __builtin_amdgcn_fence(__ATOMIC_ACQUIRE, "agent");
            xb_add(&bar[XB_XGEN(b.x)], 1u);
            asm volatile("s_waitcnt vmcnt(0)" ::: "memory");
        } else {
            XB_SPIN(xb_ld(&bar[XB_XGEN(b.x)]) == gen, bar);
            __builtin_amdgcn_fence(__ATOMIC_ACQUIRE, "agent");
            asm volatile("s_waitcnt vmcnt(0)" ::: "memory");
        }
    }
    __syncthreads();
}

#ifndef PROBE_ATT
#define PROBE_ATT 1
#endif
#ifndef PROBE_P0
#define PROBE_P0 1
#endif
#ifndef PROBE_FF1
#define PROBE_FF1 1
#endif
#ifndef PROBE_DIL
#define PROBE_DIL 1
#endif
#ifndef PROBE_SYNC
#define PROBE_SYNC 1
#endif
#define GSYNC() do { for (int rs_ = 0; rs_ < PROBE_SYNC; ++rs_) { XcdBarrier xb_; xb_.bar = (unsigned*)(args.ws + WS_CTL); xb_.x = xb_xcc_id(); xb_.st = (volatile LAS unsigned*)(ldsl + XB_LDS_OFF); xcd_barrier(xb_); } } while (0)
__global__ void __launch_bounds__(512, 2) mega_fwd(Args args) {
    extern __shared__ __attribute__((aligned(16))) unsigned char lds[];
    cg::grid_group grid = cg::this_grid();
    const int tid = threadIdx.x, lane = tid & 63, wave = __builtin_amdgcn_readfirstlane(tid >> 6);
    const int G = gridDim.x, bx = blockIdx.x;
    const int gw = bx * 8 + wave, NGW = G * 8;
    unsigned char* ws = args.ws;
    LAS unsigned char* ldsl = (LAS unsigned char*)lds;
    const float* x_in = args.in[0]; const float* g_mix = args.in[1]; const float* g_ffn = args.in[2]; const float* g_fin = args.in[3];
    const float* table = args.in[4]; const float* w_in_e = args.in[5]; const float* w_fnet = args.in[6];
    float* out = args.out;
    bf16r* H = (bf16r*)(ws + WS_H); bf16r* CAT = (bf16r*)(ws + WS_CAT); float* WCS = (float*)(ws + WS_WCS);
    bf16r* DFT = (bf16r*)(ws + WS_DFT);
    volatile LAS unsigned* xst = (volatile LAS unsigned*)(ldsl + XB_LDS_OFF);
    if (tid < 2) xst[tid] = 0u;
    unsigned* xwords = (unsigned*)(ws + WS_CTL);
    if (bx == 0) for (int i = tid; i < XCD_BAR_WORDS; i += 512) __hip_atomic_store(xwords + i, 0u, __ATOMIC_RELAXED, __HIP_MEMORY_SCOPE_AGENT);
    __syncthreads();
    grid.sync();
    (void)xcd_barrier_post(xwords, xst);

#ifndef SKIP_P0
    for (int rep0_ = 0; rep0_ < PROBE_P0; ++rep0_)
    {
        LAS float* scr = (LAS float*)(ldsl + wave * 16384);
        int jb = 0;
        for (int it = gw; it < TJ_TOTAL; it += NGW) {
            while (it >= g_jobs[jb].items_end) ++jb;
            const TJob J = g_jobs[jb]; const int start = jb == 0 ? 0 : g_jobs[jb - 1].items_end;
            transpose_item(args.in[J.in_idx] + J.src_off, J.ldw, J.K, J.ncols, (bf16r*)(ws + J.dst_off), scr, it - start, lane, J.qcols);
        }
        { float* DT = (float*)(ws + WS_DTAB);
          for (int idx = bx * 512 + tid; idx < 36 * 640; idx += G * 512) { const int hb = idx / 640, i = idx - hb * 640, o = i - 320, br_ = hb / 12, head_ = hb - br_ * 12; const int dil_ = br_ == 0 ? 1 : (br_ == 1 ? 4 : 16);
              DT[idx] = (o >= -64 && o <= 64) ? table[att::t5_bucket(o * dil_) * 20 + head_] * (1.f / att::SCALE) : att::NEGBIG; } }
        for (int idx = bx * 512 + tid; idx < 2 * 4 * 128 * 256; idx += G * 512) {
            const int j = idx & 255, c = (idx >> 8) & 127, lg = idx >> 15, e = j & 127;
            const float* wf = w_fnet + (size_t)lg * 128 * 128 + e; float s = 0.f;
            for (int cp = 0; cp < 128; ++cp) { const float ph = (float)((c * cp) & 127) * (1.f / 128.f); const float tr = (j < 128) ? __builtin_amdgcn_cosf(ph) : __builtin_amdgcn_sinf(ph); s += tr * wf[cp * 128]; }
            WCS[idx] = s * (1.f / 1024.f);
        }
        for (long v = (long)bx * 512 + tid; v < (long)SEQ * 1024; v += (long)G * 512) {
            const int r = (int)(v >> 10), k0 = ((int)v & 1023) * 8; const int sp = ((r & 4095) << 1) | (r >> 12); const bool is_sin = k0 >= 4096; const int kk = k0 & 4095;
            float t[8];
#pragma unroll
            for (int i = 0; i < 8; ++i) { const float ph = (float)((sp * (kk + i)) & 8191) * (1.f / 8192.f); t[i] = is_sin ? -__builtin_amdgcn_sinf(ph) : __builtin_amdgcn_cosf(ph); }
            v4u o; o.x = pk2(t[0], t[1]); o.y = pk2(t[2], t[3]); o.z = pk2(t[4], t[5]); o.w = pk2(t[6], t[7]);
            *(v4u*)(DFT + (size_t)r * 8192 + k0) = o;
        }
        rms_pair_phase(x_in, g_mix, H, (bf16r*)(ws + WS_HPM), gw, NGW, lane);
    }
    GSYNC();
    for (int item = bx; item < 2 * 4 * 32; item += G) {
        const int l = item >> 7, g = (item >> 5) & 3, k0 = (item & 31) * 64;
        LAS float* As = (LAS float*)ldsl;
        __syncthreads();
        for (int i = 0; i < 16; ++i) { const int c = tid & 127, kk = (tid >> 7) + 4 * i; As[c * 68 + kk] = w_in_e[((size_t)l * 2048 + k0 + kk) * 5120 + 4608 + g * 128 + c]; }
        __syncthreads();
        const int j = tid & 255, kh = tid >> 8;
        float acc[32];
#pragma unroll
        for (int i = 0; i < 32; ++i) acc[i] = 0.f;
        const float* wc = WCS + ((size_t)(l * 4 + g) * 128) * 256 + j;
        for (int c = 0; c < 128; ++c) { const float w = wc[c * 256];
#pragma unroll
            for (int q = 0; q < 8; ++q) { const f32x4 a4 = *(const LAS f32x4*)(As + c * 68 + kh * 32 + 4 * q); acc[4 * q] += a4.x * w; acc[4 * q + 1] += a4.y * w; acc[4 * q + 2] += a4.z * w; acc[4 * q + 3] += a4.w * w; } }
        bf16r* dst = (bf16r*)(ws + WS_WIN_E + (size_t)l * 22 * MiB) + (size_t)(4608 + (j >> 7) * 512 + g * 128 + (j & 127)) * 2048 + k0 + kh * 32;
#pragma unroll
        for (int q = 0; q < 4; ++q) { v4u o; o.x = pk2(acc[8 * q], acc[8 * q + 1]); o.y = pk2(acc[8 * q + 2], acc[8 * q + 3]); o.z = pk2(acc[8 * q + 4], acc[8 * q + 5]); o.w = pk2(acc[8 * q + 6], acc[8 * q + 7]); *(v4u*)(dst + 8 * q) = o; }
    }
    GSYNC();
#endif

#pragma unroll 1
    for (int layer = 0; layer < NLAYER; ++layer) {
        const int lj = layer >> 1; const bool even = (layer & 1) == 0;
        const float* resid_base = (layer == 0) ? x_in : out;
        if (even) {
            const bf16r* WIN = (const bf16r*)(ws + WS_WIN_E + (size_t)lj * 22 * MiB);
            bf16r* QKV = (bf16r*)(ws + WS_PROJ); bf16r* YT = (bf16r*)(ws + WS_YT);
            { pg8::Gemm g{H, WIN, DM, DM, DM}; pg8::Order S; S.init(SEQ, EV_QKV, 1, G, bx);
              pg8::EpiBf16<0, false> E{QKV, EV_QKV, 0};
#ifndef SKIP_G0
              pg8::gemm_phase<pg8::EpiBf16<0, false>, pg8::Order, true, true>(ldsl, g, S, E);
#endif
            }
            { pg8::Gemm g{WIN + (size_t)EV_QKV * DM, (const bf16r*)(ws + WS_HPM), DM, DM, DM}; pg8::Order S; S.init(1024, SEQ, 1, G, (bx + G / 2) % G);
              pg8::EpiBf16<0, true> E{YT, 16384, 4096};
#ifndef SKIP_G1
              pg8::gemm_phase<pg8::EpiBf16<0, true>, pg8::Order, true, true>(ldsl, g, S, E);
#endif
            }
            GSYNC();
            { pg8::Gemm g{DFT, YT, 8192, 16384, 2048, 16, 8192}; pg8::Order S; S.init(SEQ, 512, 4, G, bx);
              pg8::EpiPart E{(float*)(ws + WS_PART), 512, (size_t)SEQ * 512};
#ifndef SKIP_G2
              pg8::gemm_phase<pg8::EpiPart, pg8::Order, true, true>(ldsl, g, S, E);
#endif
            }
            for (int rep2_ = 0; rep2_ < PROBE_DIL; ++rep2_)
            for (int u = bx; u < 12 * 3 * 32; u += G) {
                const int qbc = u & 31, hb = u >> 5, head = hb % 12, br = hb / 12; const int nqb = br == 0 ? 32 : (br == 1 ? 8 : 2);
#ifndef SKIP_DIL
                dil_attn_unit(head, br, qbc / nqb, qbc % nqb, (const att::bf16*)QKV, (bf16r*)(ws + WS_OB), (float*)(ws + WS_LSE), (const float*)(ws + WS_DTAB), (char*)lds);
#endif
            }
            GSYNC();
            {
                const bf16r* OB = (const bf16r*)(ws + WS_OB); const float* LSE = (const float*)(ws + WS_LSE); const float* PART = (const float*)(ws + WS_PART);
                int lane_m = lane; asm volatile("" : "+v"(lane_m));
#pragma unroll 2
                for (int m = gw; m < SEQ; m += NGW) {
#pragma unroll
                    for (int i = 0; i < 3; ++i) { const int v = lane_m + 64 * i, head = v >> 4;
                        const float l0 = LSE[((size_t)0 * SEQ + m) * 12 + head], l1 = LSE[((size_t)1 * SEQ + m) * 12 + head], l2 = LSE[((size_t)2 * SEQ + m) * 12 + head];
                        const float mx = fmaxf(l0, fmaxf(l1, l2)); float w0 = __builtin_amdgcn_exp2f(l0 - mx), w1 = __builtin_amdgcn_exp2f(l1 - mx), w2 = __builtin_amdgcn_exp2f(l2 - mx);
                        const float inv = 1.f / (w0 + w1 + w2); w0 *= inv; w1 *= inv; w2 *= inv;
                        const v4u a = *(const v4u*)(OB + ((size_t)0 * SEQ + m) * 1536 + v * 8), b = *(const v4u*)(OB + ((size_t)1 * SEQ + m) * 1536 + v * 8), c = *(const v4u*)(OB + ((size_t)2 * SEQ + m) * 1536 + v * 8);
                        v4u o;
#pragma unroll
                        for (int q = 0; q < 4; ++q) { const float lo = w0 * bf2f((unsigned short)(a[q] & 0xffff)) + w1 * bf2f((unsigned short)(b[q] & 0xffff)) + w2 * bf2f((unsigned short)(c[q] & 0xffff));
                            const float hi2 = w0 * bf2f((unsigned short)(a[q] >> 16)) + w1 * bf2f((unsigned short)(b[q] >> 16)) + w2 * bf2f((unsigned short)(c[q] >> 16)); o[q] = pk2(lo, hi2); }
                        *(v4u*)(CAT + (size_t)m * DM + v * 8) = o; }
                    { f32x4 s0 = (f32x4){0.f, 0.f, 0.f, 0.f}, s1 = s0;
#pragma unroll
                      for (int kc = 0; kc < 4; ++kc) { const float* p = PART + ((size_t)kc * SEQ + m) * 512 + lane_m * 8; s0 += *(const f32x4*)p; s1 += *(const f32x4*)(p + 4); }
                      v4u o; o.x = pk2(s0.x, s0.y); o.y = pk2(s0.z, s0.w); o.z = pk2(s1.x, s1.y); o.w = pk2(s1.z, s1.w);
                      *(v4u*)(CAT + (size_t)m * DM + 1536 + lane_m * 8) = o; }
                }
            }
            GSYNC();
        } else {
            const bf16r* WQ = (const bf16r*)(ws + WS_WQKV_O + (size_t)lj * 24 * MiB);
            bf16r* PROJ = (bf16r*)(ws + WS_PROJ);
            { pg8::Gemm g{H, WQ, DM, DM, DM}; pg8::Order S; S.init(SEQ, OD_N, 1, G, bx);
              pg8::EpiBf16<0, false> E{PROJ, OD_N, 0};
#ifndef SKIP_G3
              pg8::gemm_phase<pg8::EpiBf16<0, false>, pg8::Order, true, true>(ldsl, g, S, E);
#endif
            }
            GSYNC();
            const float lambda_init = (layer == 1) ? 0.3555090676f : 0.5560582042f;
            float lam;
            { int lane_p = lane; asm volatile("" : "+v"(lane_p));
              const float* lq1 = args.in[9] + lj * 128; const float* lk1 = args.in[10] + lj * 128; const float* lq2 = args.in[11] + lj * 128; const float* lk2 = args.in[12] + lj * 128;
              const float sa = wave_sum(lq1[lane_p] * lk1[lane_p] + lq1[lane_p + 64] * lk1[lane_p + 64]);
              const float sb = wave_sum(lq2[lane_p] * lk2[lane_p] + lq2[lane_p + 64] * lk2[lane_p + 64]);
              lam = __builtin_bit_cast(float, __builtin_amdgcn_readfirstlane(__builtin_bit_cast(int, expf(sa) - expf(sb) + lambda_init))); }
            const bool fused_post = (G == 256);
            for (int u = bx; u < 1024; u += G) {
#ifndef SKIP_DIFF
                diff_attn_unit(u & 7, u >> 9, (u >> 3) & 63, (const att::bf16*)PROJ, (float*)(ws + WS_T), table, (char*)lds, (u == bx) || (G & 7) != 0);
                if (fused_post && (u >> 9) == 1) diff_post_block((const float*)(ws + WS_T), CAT, args.in[13] + lj * 256, lam, 1.f - lambda_init, u & 7, (u >> 3) & 63);
#endif
            }
            GSYNC();
            if (!fused_post) {
                int lane_p = lane; asm volatile("" : "+v"(lane_p));
#pragma unroll 2
                for (int m = gw; m < SEQ; m += NGW) diff_post_row((const float*)(ws + WS_T), CAT, args.in[13] + lj * 256, lam, 1.f - lambda_init, m, lane_p);
                GSYNC();
            }
        }
        { pg8::Gemm g{CAT, (const bf16r*)(ws + WS_WOUT + (size_t)layer * 8 * MiB), DM, DM, DM}; pg8::Order S; S.init(SEQ, DM, 1, G, bx);
          pg8::EpiRes E{resid_base, out, DM};
#ifndef SKIP_G4
          pg8::gemm_phase<pg8::EpiRes, pg8::Order, true, true>(ldsl, g, S, E);
#endif
            }
        GSYNC();
        rms_phase<false>(out, g_ffn + layer * DM, H, gw, NGW, lane);
        GSYNC();
        for (int rep1_ = 0; rep1_ < PROBE_FF1; ++rep1_) { pg8::Gemm g{H, (const bf16r*)(ws + WS_WFF1 + (size_t)layer * 32 * MiB), DM, DM, DM}; pg8::Order S; S.init(SEQ, DFF, 1, G, bx);
          pg8::EpiBf16<2, false> E{(bf16r*)(ws + WS_HID), DFF, 0};
#ifndef SKIP_G5
          pg8::gemm_phase<pg8::EpiBf16<2, false>, pg8::Order, true, true>(ldsl, g, S, E);
#endif
            }
        GSYNC();
        { pg8::Gemm g{(const bf16r*)(ws + WS_HID), (const bf16r*)(ws + WS_WFF2 + (size_t)layer * 32 * MiB), DFF, DFF, DFF}; pg8::Order S; S.init(SEQ, DM, 1, G, bx);
          pg8::EpiRes E{out, out, DM};
#ifndef SKIP_G6
          pg8::gemm_phase<pg8::EpiRes, pg8::Order, true, true>(ldsl, g, S, E);
#endif
            }
        GSYNC();
        if (layer < NLAYER - 1) { if (layer & 1) rms_pair_phase(out, g_mix + (layer + 1) * DM, H, (bf16r*)(ws + WS_HPM), gw, NGW, lane); else rms_phase<false>(out, g_mix + (layer + 1) * DM, H, gw, NGW, lane); GSYNC(); }
        else rms_phase<true>(out, g_fin, out, gw, NGW, lane);
    }
}

extern "C" void kernel_launch(void* const* d_in, const int* in_sizes, int n_in, void* d_out, int out_size, void* d_ws, size_t ws_size, hipStream_t stream) {
    static int grid = 0;
    if (grid == 0) {
        if (n_in != 17 || out_size != SEQ * DM || ws_size < WS_TOTAL) { fprintf(stderr, "kernel_launch: unexpected shapes: n_in %d out %d ws %zu (need %zu)\n", n_in, out_size, ws_size, (size_t)WS_TOTAL); grid = -1; return; }
        int dev = 0, cus = 0, per_cu = 0;
        (void)hipGetDevice(&dev); (void)hipDeviceGetAttribute(&cus, hipDeviceAttributeMultiprocessorCount, dev);
        if (hipFuncSetAttribute((const void*)mega_fwd, hipFuncAttributeMaxDynamicSharedMemorySize, LDS_BYTES) != hipSuccess) { fprintf(stderr, "kernel_launch: hipFuncSetAttribute failed\n"); grid = -1; return; }
        if (hipOccupancyMaxActiveBlocksPerMultiprocessor(&per_cu, (const void*)mega_fwd, 512, LDS_BYTES) != hipSuccess || per_cu < 1) { fprintf(stderr, "kernel_launch: occupancy query says %d\n", per_cu); per_cu = 1; }
        (void)hipGetLastError();
        grid = cus * per_cu;
    }
    if (grid < 0) return;
    Args a{};
    for (int i = 0; i < 17; ++i) a.in[i] = (const float*)d_in[i];
    a.out = (float*)d_out; a.ws = (unsigned char*)d_ws;
    void* kargs[] = {&a};
    const hipError_t e = hipLaunchCooperativeKernel((const void*)mega_fwd, dim3(grid), dim3(512), kargs, LDS_BYTES, stream);
    if (e != hipSuccess) fprintf(stderr, "kernel_launch: cooperative launch failed: %s (grid %d)\n", hipGetErrorString(e), grid);
}
```

```cpp
#include <hip/hip_runtime.h>
#include <hip/hip_bf16.h>
#include <hip/hip_cooperative_groups.h>
#include <cstdio>
#include <cstdint>
namespace cg = cooperative_groups;

namespace pg8 {
#define PG8_LAS __attribute__((address_space(3)))
typedef unsigned short bf16_t;
typedef short bf16x8 __attribute__((ext_vector_type(8)));
typedef float f32x4 __attribute__((ext_vector_type(4)));
typedef unsigned u32x4 __attribute__((ext_vector_type(4)));
constexpr int BM = 256, BK = 64, HALF = 128, HTB = HALF * BK * 2  , STAGE_BYTES = 8 * HTB, NXCD = 8, WGM = 8;

__host__ __device__ __forceinline__ int lds_byte(int r, int c) { const int st = (r >> 4) * 2 + (c >> 5), rr = r & 15, cc = c & 31, ob = rr * 64 + cc * 2; return st * 1024 + (ob ^ (((ob >> 9) & 1) << 5)); }
__host__ __device__ __forceinline__ void stage_rc(int b, int& R, int& C) { const int st = b / 1024, sb = b % 1024, swz = sb ^ (((sb >> 9) & 1) << 5); R = (st >> 1) * 16 + swz / 64; C = (st & 1) * 32 + (swz % 64) / 2; }
__host__ __device__ __forceinline__ int perm32(int rho) { const int n = rho >> 4, i = rho & 15; return 8 * (i >> 2) + 4 * n + (i & 3); }

struct Unit { int pm, pn, kc; };
struct Gemm { const bf16_t* A; const bf16_t* Bt; int lda, ldb, K; int bsplit_pm = 1 << 30; int bsplit_off = 0; };

struct Order {
    int nM, nN, nK, nwg, tot, G, c;
    __device__ void init(int M, int N, int nK_, int G_, int c_) { nM = M / BM; nN = N / BM; nK = nK_; nwg = nM * nN; tot = nwg * nK; G = G_; c = c_; }
    __device__ bool next(int i, Unit& u) const {
        const long L = (long)i * G + c; if (L >= tot) return false;
        const int kc = (int)(L / nwg); int wgid = (int)(L % nwg);
        { const int q = nwg / NXCD, r = nwg % NXCD, xcd = wgid % NXCD, off = wgid / NXCD; wgid = (xcd < r ? xcd * (q + 1) : r * (q + 1) + (xcd - r) * q) + off; }
        const int nig = WGM * nN, gid = wgid / nig, fm = gid * WGM, gsz = (nM - fm) < WGM ? (nM - fm) : WGM;
        u.pm = fm + ((wgid % nig) % gsz); u.pn = (wgid % nig) / gsz; u.kc = kc; return true;
    }
    __device__ __forceinline__ void a_ready(const Unit&) const {}
    __device__ __forceinline__ void done(const Unit&) const {}
};

__device__ __forceinline__ unsigned cvt_pk_bf16(float lo, float hi) { unsigned r; asm volatile("v_cvt_pk_bf16_f32 %0, %1, %2" : "=v"(r) : "v"(lo), "v"(hi)); return r; }

template <int ACT, bool YSPLIT> struct EpiBf16 {
    static constexpr bool PERM = true, AFTER_DRAIN = false;
    bf16_t* O; int ldc; int ysplit_cols;
    __device__ __forceinline__ void operator()(const f32x4 (&acc)[2][2][4][2], const Unit& u, int wr, int wc, int fr, int fq) const {
        int rowt = u.pm * BM, colt = u.pn * BM;
        if (YSPLIT) { rowt = (u.pm & 1) * BM; colt = (u.pn >> 4) * (2 * ysplit_cols) + (u.pm >> 1) * ysplit_cols + (u.pn & 15) * BM; }
        const int row0 = rowt + wr * 64 + fr; const int col0 = colt + wc * 32 + 8 * fq;
#pragma unroll
        for (int ai = 0; ai < 2; ++ai)
#pragma unroll
            for (int m = 0; m < 4; ++m) { bf16_t* rowp = O + (size_t)(row0 + ai * HALF + m * 16) * ldc + col0;
#pragma unroll
                for (int bj = 0; bj < 2; ++bj) { f32x4 v0 = acc[ai][bj][m][0], v1 = acc[ai][bj][m][1];
                    if (ACT == 2) {
#pragma unroll
                        for (int q = 0; q < 4; ++q) { const float a = fmaxf(v0[q], 0.f), b = fmaxf(v1[q], 0.f); v0[q] = a * a; v1[q] = b * b; } }
                    u32x4 w; w.x = cvt_pk_bf16(v0[0], v0[1]); w.y = cvt_pk_bf16(v0[2], v0[3]); w.z = cvt_pk_bf16(v1[0], v1[1]); w.w = cvt_pk_bf16(v1[2], v1[3]);
                    *(u32x4*)(rowp + bj * HALF) = w; } }
    }
};
struct EpiRes {
    static constexpr bool PERM = true, AFTER_DRAIN = false;
    const float* base; float* out; int ldc;
    __device__ __forceinline__ void operator()(const f32x4 (&acc)[2][2][4][2], const Unit& u, int wr, int wc, int fr, int fq) const {
        const int col0 = u.pn * BM + wc * 32 + 8 * fq;
#pragma unroll
        for (int ai = 0; ai < 2; ++ai)
#pragma unroll
            for (int m = 0; m < 4; ++m) { const size_t off = (size_t)(u.pm * BM + ai * HALF + wr * 64 + m * 16 + fr) * ldc + col0;
#pragma unroll
                for (int bj = 0; bj < 2; ++bj) { const f32x4 b0 = *(const f32x4*)(base + off + bj * HALF), b1 = *(const f32x4*)(base + off + bj * HALF + 4);
                    *(f32x4*)(out + off + bj * HALF) = b0 + acc[ai][bj][m][0]; *(f32x4*)(out + off + bj * HALF + 4) = b1 + acc[ai][bj][m][1]; }
                asm volatile("" ::: "memory"); }
    }
};
struct EpiPart {
    static constexpr bool PERM = true, AFTER_DRAIN = false;
    bf16_t* out; int ldc; size_t kstride;
    __device__ __forceinline__ void operator()(const f32x4 (&acc)[2][2][4][2], const Unit& u, int wr, int wc, int fr, int fq) const {
        const int col0 = u.pn * BM + wc * 32 + 8 * fq; bf16_t* o = out + (size_t)u.kc * kstride;
#pragma unroll
        for (int ai = 0; ai < 2; ++ai)
#pragma unroll
            for (int m = 0; m < 4; ++m) { const int r = u.pm * BM + ai * HALF + wr * 64 + m * 16 + fr; const size_t off = (size_t)(((r & 4095) << 1) | (r >> 12)) * ldc + col0;
#pragma unroll
                for (int bj = 0; bj < 2; ++bj) { const f32x4 v0 = acc[ai][bj][m][0], v1 = acc[ai][bj][m][1];
                    u32x4 w; w.x = cvt_pk_bf16(v0[0], v0[1]); w.y = cvt_pk_bf16(v0[2], v0[3]); w.z = cvt_pk_bf16(v1[0], v1[1]); w.w = cvt_pk_bf16(v1[2], v1[3]);
                    *(u32x4*)(o + off + bj * HALF) = w; } }
    }
};

template <class Epi, class Sched, bool ALIGN_EPI = false, bool SP2 = false>
__device__ __forceinline__ void gemm_phase(PG8_LAS unsigned char* lds, const Gemm g, const Sched& S, const Epi& E) {
    int tid_ = threadIdx.x; asm volatile("" : "+v"(tid_));
    const int tid = tid_, wid = __builtin_amdgcn_readfirstlane(tid >> 6), lane = tid & 63, wr = wid >> 2, wc = wid & 3, fr = lane & 15, fq = lane >> 4;
    const int K = g.K, nt = K / BK;
    unsigned voffA[2], voffB[2];
#pragma unroll
    for (int i = 0; i < 2; ++i) { int R, C; stage_rc(tid * 16 + i * 8192, R, C); const int Rb = Epi::PERM ? ((R & ~31) + perm32(R & 31)) : R;
        voffA[i] = (unsigned)(R * g.lda + C) * 2u; voffB[i] = (unsigned)(Rb * g.ldb + C) * 2u; }
    const size_t kstep = (size_t)(BK * 2);
    const size_t hstepA = (size_t)HALF * g.lda * 2, hstepB = (size_t)HALF * g.ldb * 2;
    const size_t tstepA = 2 * hstepA, tstepB = 2 * hstepB; const size_t ksplit = (size_t)K * 2;
    const unsigned ldsw = (unsigned)wid * 1024u;
    const int aoff = lds_byte(wr * 64 + fr, fq * 8), boff = lds_byte(wc * 32 + fr, fq * 8);
#define PG8_SA(b, h) (((b) * 2 + (h)) * HTB)
#define PG8_SB(b, h) ((4 + (b) * 2 + (h)) * HTB)
#define PG8_STAGE(bufoff, gbase, voff) do { _Pragma("unroll") for (int _i = 0; _i < 2; ++_i) \
        __builtin_amdgcn_global_load_lds((const unsigned*)((const char*)(gbase) + (voff)[_i]), (PG8_LAS unsigned*)(lds + (bufoff) + ldsw + _i * 8192), 16, 0, 0); } while (0)
#define PG8_LDA(dst, b, h) do { _Pragma("unroll") for (int m = 0; m < 4; ++m) _Pragma("unroll") for (int k = 0; k < 2; ++k) dst[m][k] = *(const PG8_LAS bf16x8*)(lds + PG8_SA(b, h) + aoff + m * 2048 + k * 1024); } while (0)
#define PG8_LDB(dst, b, h) do { _Pragma("unroll") for (int n = 0; n < 2; ++n) _Pragma("unroll") for (int k = 0; k < 2; ++k) dst[n][k] = *(const PG8_LAS bf16x8*)(lds + PG8_SB(b, h) + boff + n * 2048 + k * 1024); } while (0)
#define PG8_MMA(ai, bj, At, Bt) do { __builtin_amdgcn_s_setprio(1); _Pragma("unroll") for (int m = 0; m < 4; ++m) _Pragma("unroll") for (int n = 0; n < 2; ++n) _Pragma("unroll") for (int k = 0; k < 2; ++k) \
        acc[ai][bj][m][n] = __builtin_amdgcn_mfma_f32_16x16x32_bf16(Bt[n][k], At[m][k], acc[ai][bj][m][n], 0, 0, 0); __builtin_amdgcn_s_setprio(0); } while (0)
#define PG8_WAIT_V(n) asm volatile("s_waitcnt vmcnt(" #n ")" ::: "memory")
#define PG8_WAIT_L(n) asm volatile("s_waitcnt lgkmcnt(" #n ")" ::: "memory")
#define PG8_BAR __builtin_amdgcn_s_barrier()
#define PG8_SCHED __builtin_amdgcn_sched_barrier(0)
    Unit cur, nxt; int ui = 0;
    if (!S.next(0, cur)) return;
    f32x4 acc[2][2][4][2];
#pragma unroll
    for (int a = 0; a < 2; ++a)
#pragma unroll
        for (int b = 0; b < 2; ++b)
#pragma unroll
            for (int m = 0; m < 4; ++m)
#pragma unroll
                for (int n = 0; n < 2; ++n) acc[a][b][m][n] = (f32x4){0.f, 0.f, 0.f, 0.f};
    bf16x8 At[4][2], B0[2][2], B1[2][2];
    const char* cA = (const char*)g.A + (size_t)cur.pm * tstepA + (size_t)cur.kc * ksplit; const char* cB = (const char*)g.Bt + (size_t)cur.pn * tstepB + (size_t)cur.kc * ksplit + (cur.pm >= g.bsplit_pm ? (size_t)g.bsplit_off * 2 : (size_t)0);
    S.a_ready(cur);
    if constexpr (SP2) {
        PG8_STAGE(PG8_SB(0, 0), cB, voffB); PG8_STAGE(PG8_SB(0, 1), cB + hstepB, voffB); PG8_STAGE(PG8_SA(0, 0), cA, voffA); PG8_STAGE(PG8_SA(0, 1), cA + hstepA, voffA);
        if (wr == 1) PG8_BAR;
        PG8_WAIT_V(2); PG8_BAR;
        PG8_STAGE(PG8_SB(1, 0), cB + kstep, voffB); PG8_STAGE(PG8_SA(1, 0), cA + kstep, voffA); PG8_STAGE(PG8_SB(1, 1), cB + hstepB + kstep, voffB);
        PG8_WAIT_V(6); PG8_BAR;
    } else {
        PG8_STAGE(PG8_SB(0, 0), cB, voffB); PG8_STAGE(PG8_SA(0, 0), cA, voffA); PG8_STAGE(PG8_SB(0, 1), cB + hstepB, voffB); PG8_STAGE(PG8_SA(0, 1), cA + hstepA, voffA);
        if (wr == 1) PG8_BAR;
        PG8_WAIT_V(4); PG8_BAR;
        PG8_STAGE(PG8_SB(1, 0), cB + kstep, voffB); PG8_STAGE(PG8_SA(1, 0), cA + kstep, voffA); PG8_STAGE(PG8_SB(1, 1), cB + hstepB + kstep, voffB);
        PG8_WAIT_V(6); PG8_BAR;
    }
    for (;;) {
        const bool has_next = S.next(ui + 1, nxt);
        const char* nA = has_next ? (const char*)g.A + (size_t)nxt.pm * tstepA + (size_t)nxt.kc * ksplit : cA; const char* nB = has_next ? (const char*)g.Bt + (size_t)nxt.pn * tstepB + (size_t)nxt.kc * ksplit + (nxt.pm >= g.bsplit_pm ? (size_t)g.bsplit_off * 2 : (size_t)0) : cB;
        for (int t = 0; t < nt; t += 2) {
            const bool last = (t == nt - 2);
            const char* a1 = cA + (size_t)(t + 1) * kstep;
            const char* a2 = last ? nA : cA + (size_t)(t + 2) * kstep; const char* b2 = last ? nB : cB + (size_t)(t + 2) * kstep;
            const char* a3 = a2 + kstep; const char* b3 = b2 + kstep;
            if (last && has_next) S.a_ready(nxt);
            if constexpr (SP2) {
            PG8_LDB(B0, 0, 0); PG8_LDB(B1, 0, 1); PG8_SCHED; PG8_LDA(At, 0, 0); PG8_STAGE(PG8_SA(1, 1), a1 + hstepA, voffA);
            PG8_WAIT_V(8); PG8_WAIT_L(0); PG8_BAR; PG8_MMA(0, 0, At, B0); PG8_MMA(0, 1, At, B1); PG8_BAR; PG8_SCHED;
            PG8_LDA(At, 0, 1); PG8_STAGE(PG8_SB(0, 0), b2, voffB); PG8_STAGE(PG8_SB(0, 1), b2 + hstepB, voffB); PG8_STAGE(PG8_SA(0, 0), a2, voffA);
            PG8_WAIT_V(8); PG8_WAIT_L(0); PG8_BAR; PG8_MMA(1, 0, At, B0); PG8_MMA(1, 1, At, B1); PG8_BAR; PG8_SCHED;
            PG8_LDB(B0, 1, 0); PG8_LDB(B1, 1, 1); PG8_SCHED; PG8_LDA(At, 1, 0); PG8_STAGE(PG8_SA(0, 1), a2 + hstepA, voffA);
            PG8_WAIT_V(8); PG8_WAIT_L(0); PG8_BAR; PG8_MMA(0, 0, At, B0); PG8_MMA(0, 1, At, B1); PG8_BAR; PG8_SCHED;
            PG8_LDA(At, 1, 1); PG8_STAGE(PG8_SB(1, 0), b3, voffB); PG8_STAGE(PG8_SB(1, 1), b3 + hstepB, voffB); PG8_STAGE(PG8_SA(1, 0), a3, voffA);
            PG8_WAIT_V(8); PG8_WAIT_L(0); PG8_BAR; PG8_MMA(1, 0, At, B0); PG8_MMA(1, 1, At, B1); PG8_BAR; PG8_SCHED;
            } else {
            PG8_LDB(B0, 0, 0); PG8_SCHED; PG8_LDA(At, 0, 0); PG8_STAGE(PG8_SA(1, 1), a1 + hstepA, voffA);
            PG8_WAIT_L(8); PG8_BAR; PG8_WAIT_L(0); PG8_MMA(0, 0, At, B0); PG8_BAR; PG8_SCHED;
            PG8_LDB(B1, 0, 1); PG8_STAGE(PG8_SB(0, 0), b2, voffB);
            PG8_BAR; PG8_WAIT_L(0); PG8_MMA(0, 1, At, B1); PG8_BAR;
            PG8_LDA(At, 0, 1); PG8_STAGE(PG8_SA(0, 0), a2, voffA);
            PG8_BAR; PG8_WAIT_L(0); PG8_MMA(1, 0, At, B0); PG8_BAR; PG8_SCHED;
            PG8_STAGE(PG8_SB(0, 1), b2 + hstepB, voffB);
            PG8_WAIT_V(6); PG8_BAR; PG8_MMA(1, 1, At, B1); PG8_BAR;
            PG8_LDB(B0, 1, 0); PG8_SCHED; PG8_LDA(At, 1, 0); PG8_STAGE(PG8_SA(0, 1), a2 + hstepA, voffA);
            PG8_WAIT_L(8); PG8_BAR; PG8_WAIT_L(0); PG8_MMA(0, 0, At, B0); PG8_BAR; PG8_SCHED;
            PG8_LDB(B1, 1, 1); PG8_STAGE(PG8_SB(1, 0), b3, voffB);
            PG8_BAR; PG8_WAIT_L(0); PG8_MMA(0, 1, At, B1); PG8_BAR;
            PG8_LDA(At, 1, 1); PG8_STAGE(PG8_SA(1, 0), a3, voffA);
            PG8_BAR; PG8_WAIT_L(0); PG8_MMA(1, 0, At, B0); PG8_BAR; PG8_SCHED;
            PG8_STAGE(PG8_SB(1, 1), b3 + hstepB, voffB);
            PG8_WAIT_V(6); PG8_BAR; PG8_MMA(1, 1, At, B1); PG8_BAR;
            }
        }
        if constexpr (ALIGN_EPI) { if (wr == 0) PG8_BAR; }
        if constexpr (!Epi::AFTER_DRAIN) { E(acc, cur, wr, wc, fr, fq); S.done(cur); }
        if (!has_next) break;
#pragma unroll
        for (int a = 0; a < 2; ++a)
#pragma unroll
            for (int b = 0; b < 2; ++b)
#pragma unroll
                for (int m = 0; m < 4; ++m)
#pragma unroll
                    for (int n = 0; n < 2; ++n) acc[a][b][m][n] = (f32x4){0.f, 0.f, 0.f, 0.f};
        cur = nxt; cA = nA; cB = nB; ++ui;
        if constexpr (ALIGN_EPI) { if (wr == 1) PG8_BAR; }
    }
    PG8_WAIT_V(0);
    if constexpr (!ALIGN_EPI) { if (wr == 0) PG8_BAR; }
    PG8_BAR;
    if constexpr (Epi::AFTER_DRAIN) { E.fused(acc, cur, wr, wc, fr, fq, lds, wid, lane); S.done(cur); }
#undef PG8_SA
#undef PG8_SB
#undef PG8_STAGE
#undef PG8_LDA
#undef PG8_LDB
#undef PG8_MMA
#undef PG8_WAIT_V
#undef PG8_WAIT_L
#undef PG8_BAR
#undef PG8_SCHED
}
}
namespace att {
using bf16 = __hip_bfloat16;
constexpr int   D = 128, NW = 8, QBLK = 32, KVBLK = 64;
constexpr float SCALE = 0.088388347648318440f;
constexpr float THR = 8.f;
constexpr float CL2 = SCALE * 1.4426950408889634f;
constexpr float NEGBIG = -3.0e38f;
constexpr int SHM_V = KVBLK * D * 2, SHM_K = KVBLK * D * 2;
constexpr int LDS_WS = 2 * SHM_V + 2 * SHM_K, LDS_TAB = LDS_WS + NW * 64 * 4, TAB_FLOATS = 2048, LDS_ATT_END = LDS_TAB + TAB_FLOATS * 4;
using bf16x8 = __attribute__((ext_vector_type(8))) short;
using s16x4  = __attribute__((ext_vector_type(4))) short;
using f32x16 = __attribute__((ext_vector_type(16))) float;
using f32x8  = __attribute__((ext_vector_type(8))) float;
using u32x4  = __attribute__((ext_vector_type(4))) unsigned;
#define KSWZ(row, colB) ((row) * 256 + ((colB) ^ (((row) & 7) << 4)))
#define SBAR() __builtin_amdgcn_sched_barrier(0)
__device__ __forceinline__ int crow(int r, int hi) { return (r & 3) + 8 * (r >> 2) + 4 * hi; }
__device__ __forceinline__ unsigned cvtpk(float lo, float hi) {
  unsigned r; asm volatile("v_cvt_pk_bf16_f32 %0, %1, %2" : "=v"(r) : "v"(lo), "v"(hi)); return r;
}
template <typename TIn> struct Stage;
template <> struct Stage<bf16>  { using T = bf16x8;
  __device__ static __forceinline__ T ld8(const bf16* p) { return *reinterpret_cast<const bf16x8*>(p); }
  __device__ static __forceinline__ bf16x8 tobf(T x) { return x; } };
template <> struct Stage<float> { using T = f32x8;
  __device__ static __forceinline__ T ld8(const float* p) { return *reinterpret_cast<const f32x8*>(p); }
  __device__ static __forceinline__ bf16x8 tobf(T x) {
    u32x4 w = {cvtpk(x[0], x[1]), cvtpk(x[2], x[3]), cvtpk(x[4], x[5]), cvtpk(x[6], x[7])}; return *reinterpret_cast<bf16x8*>(&w); } };

__device__ __forceinline__ void partialSM(f32x16& p0, f32x16& p1, float& m_reg, float& mn, float& alpha) {
  constexpr float C = SCALE * 1.4426950408889634f;
  float pmax = p0[0]; for (int r = 1; r < 16; ++r) pmax = fmaxf(pmax, p0[r]); for (int r = 0; r < 16; ++r) pmax = fmaxf(pmax, p1[r]);
  { auto rr = __builtin_amdgcn_permlane32_swap(__float_as_uint(pmax), __float_as_uint(pmax), false, false);
    pmax = fmaxf(__uint_as_float(rr[0]), __uint_as_float(rr[1])); }
  if (__builtin_expect(__all(pmax - m_reg <= THR / SCALE), 1)) { mn = m_reg; alpha = 1.f; }
  else { mn = fmaxf(m_reg, pmax); alpha = __builtin_amdgcn_exp2f((m_reg - mn) * C); m_reg = mn; }
  float mnC = -mn * C;
  for (int r = 0; r < 16; ++r) p0[r] = fmaf(p0[r], C, mnC); for (int r = 0; r < 16; ++r) p1[r] = fmaf(p1[r], C, mnC);
  for (int r = 0; r < 16; ++r) p0[r] = __builtin_amdgcn_exp2f(p0[r]);
}
__device__ __forceinline__ void partialSM0(f32x16& p0, f32x16& p1, float& m_reg, float& alpha, const bool first) {
  constexpr float THR2 = THR * 1.4426950408889634f;
  float pmax = p0[0]; for (int r = 1; r < 16; ++r) pmax = fmaxf(pmax, p0[r]); for (int r = 0; r < 16; ++r) pmax = fmaxf(pmax, p1[r]);
  { auto rr = __builtin_amdgcn_permlane32_swap(__float_as_uint(pmax), __float_as_uint(pmax), false, false);
    pmax = fmaxf(__uint_as_float(rr[0]), __uint_as_float(rr[1])); }
  if (!first && __builtin_expect(__all(pmax <= THR2), 1)) { alpha = 1.f; }
  else { const float dl = first ? pmax : fmaxf(pmax, 0.f); m_reg += dl; alpha = first ? 1.f : __builtin_amdgcn_exp2f(-dl);
    for (int r = 0; r < 16; ++r) { p0[r] -= dl; p1[r] -= dl; } }
  for (int r = 0; r < 16; ++r) p0[r] = __builtin_amdgcn_exp2f(p0[r]);
}
__device__ __forceinline__ void finishSM(f32x16& p0, f32x16& p1, float alpha, float& l_reg, bf16x8& pa0, bf16x8& pa1, bf16x8& pa2, bf16x8& pa3) {
  for (int r = 0; r < 16; ++r) p1[r] = __builtin_amdgcn_exp2f(p1[r]);
  float ps = 0; for (int r = 0; r < 16; ++r) ps += p0[r]; for (int r = 0; r < 16; ++r) ps += p1[r];
  { auto rr = __builtin_amdgcn_permlane32_swap(__float_as_uint(ps), __float_as_uint(ps), false, false);
    ps = __uint_as_float(rr[0]) + __uint_as_float(rr[1]); }
  l_reg = l_reg * alpha + ps;
#define PK4(P, BASE, OUT) do { unsigned a0 = cvtpk(P[BASE + 0], P[BASE + 1]), a1 = cvtpk(P[BASE + 2], P[BASE + 3]);   \
    unsigned b0 = cvtpk(P[BASE + 4], P[BASE + 5]), b1 = cvtpk(P[BASE + 6], P[BASE + 7]);                              \
    auto r0 = __builtin_amdgcn_permlane32_swap(a0, b0, false, false); auto r1 = __builtin_amdgcn_permlane32_swap(a1, b1, false, false); \
    u32x4 w = {r0[0], r1[0], r0[1], r1[1]}; OUT = *reinterpret_cast<bf16x8*>(&w); } while (0)
  PK4(p0, 0, pa0); PK4(p0, 8, pa1); PK4(p1, 0, pa2); PK4(p1, 8, pa3);
#undef PK4
}
__device__ __forceinline__ void qkt(f32x16& p0, f32x16& p1, const bf16* Ks, const bf16x8* qr, int r32, int hi) {
  for (int d0 = 0; d0 < 8; ++d0) { int cb = (d0 * 16 + hi * 8) * 2;
    bf16x8 b0 = *reinterpret_cast<const bf16x8*>((const char*)Ks + KSWZ(r32, cb));
    bf16x8 b1 = *reinterpret_cast<const bf16x8*>((const char*)Ks + KSWZ(32 + r32, cb));
    p0 = __builtin_amdgcn_mfma_f32_32x32x16_bf16(b0, qr[d0], p0, 0, 0, 0);
    p1 = __builtin_amdgcn_mfma_f32_32x32x16_bf16(b1, qr[d0], p1, 0, 0, 0); }
}
__device__ __forceinline__ int v_st(int k, int c) { const int kk = (k & ~0xC) | ((k & 4) << 1) | ((k & 8) >> 1); return ((kk >> 3) * 4 + (c >> 5)) * 512 + ((kk & 7) * 32 + (c & 31)) * 2; }
__device__ __forceinline__ int v_rd_base(int lane) { return ((lane & 3) << 3) | (((lane >> 2) & 3) << 6) | (((lane >> 4) & 1) << 5) | (((lane >> 5) & 1) << 8); }
constexpr int v_rd_off(int d0, int ks, int half) { return d0 * 512 + ks * 4096 + half * 2048; }
template <int OFF> __device__ __forceinline__ s16x4 tr_read(int vb) {
  s16x4 r; asm volatile("ds_read_b64_tr_b16 %0, %1 offset:%2" : "=&v"(r) : "v"(vb), "i"(OFF) : "memory"); return r;
}
template <int D0> __device__ __forceinline__ void pv_one(f32x16& od, int vb, bf16x8 pa0, bf16x8 pa1, bf16x8 pa2, bf16x8 pa3) {
  const s16x4 l0 = tr_read<v_rd_off(D0, 0, 0)>(vb), h0 = tr_read<v_rd_off(D0, 0, 1)>(vb), l1 = tr_read<v_rd_off(D0, 1, 0)>(vb), h1 = tr_read<v_rd_off(D0, 1, 1)>(vb);
  const s16x4 l2 = tr_read<v_rd_off(D0, 2, 0)>(vb), h2 = tr_read<v_rd_off(D0, 2, 1)>(vb), l3 = tr_read<v_rd_off(D0, 3, 0)>(vb), h3 = tr_read<v_rd_off(D0, 3, 1)>(vb);
  asm volatile("s_waitcnt lgkmcnt(0)" ::: "memory"); SBAR();
#define PK(L, H) (bf16x8){L[0], L[1], L[2], L[3], H[0], H[1], H[2], H[3]}
  od = __builtin_amdgcn_mfma_f32_32x32x16_bf16(pa0, PK(l0, h0), od, 0, 0, 0);
  od = __builtin_amdgcn_mfma_f32_32x32x16_bf16(pa1, PK(l1, h1), od, 0, 0, 0);
  od = __builtin_amdgcn_mfma_f32_32x32x16_bf16(pa2, PK(l2, h2), od, 0, 0, 0);
  od = __builtin_amdgcn_mfma_f32_32x32x16_bf16(pa3, PK(l3, h3), od, 0, 0, 0);
#undef PK
}
__device__ __forceinline__ void pv_d0(f32x16* o, int vb, bf16x8 pa0, bf16x8 pa1, bf16x8 pa2, bf16x8 pa3) {
  pv_one<0>(o[0], vb, pa0, pa1, pa2, pa3); pv_one<1>(o[1], vb, pa0, pa1, pa2, pa3); pv_one<2>(o[2], vb, pa0, pa1, pa2, pa3); pv_one<3>(o[3], vb, pa0, pa1, pa2, pa3);
}
template <int KS> __device__ __forceinline__ void pv_ks(f32x16* o, int vb, bf16x8 pa) {
  const s16x4 l0 = tr_read<v_rd_off(0, KS, 0)>(vb), h0 = tr_read<v_rd_off(0, KS, 1)>(vb), l1 = tr_read<v_rd_off(1, KS, 0)>(vb), h1 = tr_read<v_rd_off(1, KS, 1)>(vb);
  const s16x4 l2 = tr_read<v_rd_off(2, KS, 0)>(vb), h2 = tr_read<v_rd_off(2, KS, 1)>(vb), l3 = tr_read<v_rd_off(3, KS, 0)>(vb), h3 = tr_read<v_rd_off(3, KS, 1)>(vb);
  asm volatile("s_waitcnt lgkmcnt(0)" ::: "memory"); SBAR();
#define PK(L, H) (bf16x8){L[0], L[1], L[2], L[3], H[0], H[1], H[2], H[3]}
  o[0] = __builtin_amdgcn_mfma_f32_32x32x16_bf16(pa, PK(l0, h0), o[0], 0, 0, 0);
  o[1] = __builtin_amdgcn_mfma_f32_32x32x16_bf16(pa, PK(l1, h1), o[1], 0, 0, 0);
  o[2] = __builtin_amdgcn_mfma_f32_32x32x16_bf16(pa, PK(l2, h2), o[2], 0, 0, 0);
  o[3] = __builtin_amdgcn_mfma_f32_32x32x16_bf16(pa, PK(l3, h3), o[3], 0, 0, 0);
#undef PK
}

__device__ __forceinline__ int t5_bucket(int rel) {
  const int base = rel > 0 ? 16 : 0; const int n = rel < 0 ? -rel : rel;
  const int v = n < 8 ? n : (n < 15 ? 8 : (n < 27 ? 9 : (n < 50 ? 10 : (n < 91 ? 11 : (n < 166 ? 12 : (n < 305 ? 13 : (n < 559 ? 14 : 15)))))));
  return base + v;
}

template <int MODE>
__device__ __forceinline__ void attn_core(const bf16* __restrict__ Qw, const bf16* __restrict__ Kh, const bf16* __restrict__ Vh, const long ldk,
                                          const int kbeg, const int NT, const int L, const int qrow, const int qw0,
                                          const float* tab, const int taboff, const float cL, const float cR,
                                          char* lds, f32x16 (&o)[4], float& l_out, float& m_out) {
  using St = Stage<bf16>;
  int tid_ = threadIdx.x; asm volatile("" : "+v"(tid_));
  const int tid = tid_, wid = __builtin_amdgcn_readfirstlane(tid >> 6), lane = tid & 63, r32 = lane & 31, hi = lane >> 5;
  bf16* V_lds = (bf16*)lds; bf16* K_lds = (bf16*)(lds + 2 * SHM_V);
  float* ws = (float*)(lds + LDS_WS) + wid * 64; float* al_l = ws + 32;
  float m_reg = (MODE == 0) ? 0.f : -1e30f, l_reg = 0; bf16x8 qr[8];
#pragma unroll
  for (int d = 0; d < 4; ++d) o[d] = f32x16{};
#pragma unroll
  for (int d0 = 0; d0 < 8; ++d0) qr[d0] = St::ld8(Qw + d0 * 16);
  const int sr = tid >> 4, sc = (tid & 15) * 8, vst0 = v_st(sr, sc), vst1 = v_st(32 + sr, sc);
  const int vb0 = (int)(uintptr_t)V_lds + v_rd_base(lane);
  struct { typename St::T vs0, vs1, ks0, ks1; } sr_[2];
#define CLAMPR(x) ((x) < 0 ? 0 : ((x) > L - 1 ? L - 1 : (x)))
#define SLOAD(i, j) do { const int k0_ = kbeg + (j) * KVBLK; const long ra_ = (long)CLAMPR(k0_ + sr) * ldk + sc, rb_ = (long)CLAMPR(k0_ + 32 + sr) * ldk + sc; \
    sr_[i].vs0 = St::ld8(Vh + ra_); sr_[i].vs1 = St::ld8(Vh + rb_); sr_[i].ks0 = St::ld8(Kh + ra_); sr_[i].ks1 = St::ld8(Kh + rb_); } while (0)
#define SWRITE(b, i) do { *(bf16x8*)((char*)V_lds + (b) * SHM_V + vst0) = St::tobf(sr_[i].vs0);          \
    *(bf16x8*)((char*)V_lds + (b) * SHM_V + vst1) = St::tobf(sr_[i].vs1); int kc = sc * 2;               \
    *(bf16x8*)((char*)K_lds + (b) * SHM_K + KSWZ(sr, kc)) = St::tobf(sr_[i].ks0);                       \
    *(bf16x8*)((char*)K_lds + (b) * SHM_K + KSWZ(32 + sr, kc)) = St::tobf(sr_[i].ks1); } while (0)
#define SWAIT() asm volatile("s_waitcnt vmcnt(4)" ::: "memory")
#define RESC(a) do { if (__any((a) < 1.f)) { if (hi == 0) al_l[r32] = (a); asm volatile("s_waitcnt lgkmcnt(0)" ::: "memory"); \
    for (int d = 0; d < 4; ++d) for (int r = 0; r < 16; ++r) o[d][r] *= al_l[crow(r, hi)]; } } while (0)
#define FILLP(P0, P1, v) do { _Pragma("unroll") for (int r = 0; r < 16; ++r) { P0[r] = (v); P1[r] = (v); } } while (0)
#define LOOKP(P0, P1, k0_) do { const float* tp_ = tab + ((k0_) - qrow + taboff + 4 * hi); \
    _Pragma("unroll") for (int r = 0; r < 16; ++r) { P0[r] = tp_[(r & 3) + 8 * (r >> 2)]; P1[r] = tp_[32 + (r & 3) + 8 * (r >> 2)]; } } while (0)
#ifdef EXP_SIMPLEINIT
#define INIT0(P0, P1, k0_) FILLP(P0, P1, cL)
#else
#define INIT0(P0, P1, k0_) do { if (k0_ + 63 - qw0 <= -559 || k0_ - qw0 - 31 >= 559) { const float cc_ = ((k0_ < qw0) ? cL : cR) - m_reg; FILLP(P0, P1, cc_); } \
    else { LOOKP(P0, P1, k0_); _Pragma("unroll") for (int r = 0; r < 16; ++r) { P0[r] -= m_reg; P1[r] -= m_reg; } } } while (0)
#endif
#define PSM(P0, P1, mn_, al_, first_) do { if (MODE == 0) partialSM0(P0, P1, m_reg, al_, first_); else partialSM(P0, P1, m_reg, mn_, al_); } while (0)
#define INITP(P0, P1, j) do { const int k0_ = kbeg + (j) * KVBLK; \
    if (MODE == 0) { INIT0(P0, P1, k0_); } \
    else { if (k0_ < 0 || k0_ >= L || k0_ - qw0 - 31 > 64 || k0_ + 63 - qw0 < -64) { FILLP(P0, P1, NEGBIG); live_ = false; } else LOOKP(P0, P1, k0_); } } while (0)
  f32x16 pA0, pA1, pB0, pB1; float mnA, mnB, alA, alB; bf16x8 pa0, pa1, pa2, pa3;
  constexpr int SE = 0, SO = 1;
  SLOAD(SE, 0); asm volatile("s_waitcnt vmcnt(0)" ::: "memory"); SWRITE(0, SE); __syncthreads();
  bool live_ = true; INITP(pA0, pA1, 0); if (MODE == 0 || live_) qkt(pA0, pA1, K_lds, qr, r32, hi); PSM(pA0, pA1, mnA, alA, true);
  SLOAD(SO, 1); if (2 < NT) SLOAD(SE, 2);
  SWAIT(); SWRITE(1, SO); __syncthreads();
  for (int j = 1; j + 1 < NT; j += 2) {
    SBAR(); live_ = true; INITP(pB0, pB1, j);
    SBAR(); if (MODE == 0 || live_) qkt(pB0, pB1, (bf16*)((char*)K_lds + SHM_K), qr, r32, hi);
    finishSM(pA0, pA1, alA, l_reg, pa0, pa1, pa2, pa3); SBAR();
    SLOAD(SO, j + 2); SBAR();
    pv_d0(o, vb0, pa0, pa1, pa2, pa3); PSM(pB0, pB1, mnB, alB, false);
    __syncthreads(); SWAIT(); SWRITE(0, SE);
    RESC(alB); __syncthreads();
    SBAR(); live_ = true; INITP(pA0, pA1, j + 1);
    SBAR(); if (MODE == 0 || live_) qkt(pA0, pA1, K_lds, qr, r32, hi);
    finishSM(pB0, pB1, alB, l_reg, pa0, pa1, pa2, pa3); SBAR();
    if (j + 3 < NT) SLOAD(SE, j + 3); SBAR();
    pv_d0(o, vb0 + (int)SHM_V, pa0, pa1, pa2, pa3); PSM(pA0, pA1, mnA, alA, false);
    __syncthreads(); SWAIT(); SWRITE(1, SO);
    RESC(alA); __syncthreads();
  }
  SBAR(); live_ = true; INITP(pB0, pB1, NT - 1);
  SBAR(); if (MODE == 0 || live_) qkt(pB0, pB1, (bf16*)((char*)K_lds + SHM_K), qr, r32, hi);
  finishSM(pA0, pA1, alA, l_reg, pa0, pa1, pa2, pa3); SBAR();
  pv_d0(o, vb0, pa0, pa1, pa2, pa3); PSM(pB0, pB1, mnB, alB, false);
  __syncthreads(); RESC(alB);
  finishSM(pB0, pB1, alB, l_reg, pa0, pa1, pa2, pa3); SBAR();
  pv_d0(o, vb0 + (int)SHM_V, pa0, pa1, pa2, pa3);
  l_out = l_reg; m_out = m_reg;
#undef CLAMPR
#undef SLOAD
#undef SWRITE
#undef SWAIT
#undef RESC
#undef FILLP
#undef LOOKP
#undef INITP
#undef PSM
#undef INIT0
}
}
namespace att3 {
using namespace att;
constexpr int VBUF = 32768, KBUF = 16384;
constexpr int L_V = 0, L_K = 2 * VBUF, L_XM = L_K + 2 * KBUF, L_XP = L_XM + 2048, L_WS = L_XP + 32768, L_TAB = L_WS + 2048, L_END = L_TAB + 8192;
__device__ __forceinline__ void attn_core3(const bf16* __restrict__ Qw, const bf16* __restrict__ Kh, const bf16* __restrict__ Vh, const long ldk, const int NT,
                                           const int qrow, const int qw0, const float* tab, const float cL, const float cR, char* lds, f32x16 (&o)[4], float& l_out) {
  using St = Stage<bf16>;
  constexpr float THR2 = THR * 1.4426950408889634f;
  int tid_ = threadIdx.x; asm volatile("" : "+v"(tid_));
  const int tid = tid_, wid = __builtin_amdgcn_readfirstlane(tid >> 6), lane = tid & 63, r32 = lane & 31, hi = lane >> 5, vh = wid & 1;
  char* V_lds = lds + L_V; char* K_lds = lds + L_K;
  float* xm = (float*)(lds + L_XM); char* xp = lds + L_XP;
  float* al_l = (float*)(lds + L_WS) + wid * 64;
  float m_reg = 0.f, l_reg = 0.f, pm_own; bf16x8 qr[8];
#pragma unroll
  for (int d = 0; d < 4; ++d) o[d] = f32x16{};
#pragma unroll
  for (int d0 = 0; d0 < 8; ++d0) qr[d0] = St::ld8(Qw + d0 * 16);
  const int vb0 = (int)(uintptr_t)V_lds + vh * 16384 + v_rd_base(lane);
  typedef __attribute__((address_space(3))) unsigned lds_u32; typedef __attribute__((address_space(3))) char lds_c;
  lds_c* const kdst = (lds_c*)K_lds + wid * 1024; lds_c* const vdst = (lds_c*)V_lds + wid * 1024;
  const int r8_ = (lane >> 2) & 7;
  const unsigned lk_off = (unsigned)(((lane >> 4) * (int)ldk + (((lane & 15) ^ ((wid * 4 + (lane >> 4)) & 7)) * 8)) * 2);
  const unsigned lv_off = (unsigned)((((r8_ & 3) + 8 * (r8_ >> 2)) * (int)ldk + 32 * (lane >> 5) + 8 * (lane & 3)) * 2);
#define DMA_K(t, kbuf) do { _Pragma("unroll") for (int i = 0; i < 2; ++i) { const char* sb_ = (const char*)Kh + ((long)((t) * KVBLK + wid * 4 + 32 * i) * ldk) * 2; \
      __builtin_amdgcn_global_load_lds((const unsigned*)(sb_ + lk_off), (lds_u32*)(kdst + (kbuf) * KBUF + i * 8192), 16, 0, 0); } } while (0)
#define DMA_V(t, vbuf) do { _Pragma("unroll") for (int i = 0; i < 4; ++i) { const int S_ = (wid >> 1) + 4 * (i & 1); \
      const char* sb_ = (const char*)Vh + ((long)((t) * KVBLK + 16 * (S_ >> 1) + 4 * (S_ & 1)) * ldk + (i >> 1) * 128 + 64 * (wid & 1)) * 2; \
      __builtin_amdgcn_global_load_lds((const unsigned*)(sb_ + lv_off), (lds_u32*)(vdst + (vbuf) * VBUF + i * 8192), 16, 0, 0); } } while (0)
#define WAITBAR() asm volatile("s_waitcnt vmcnt(0) lgkmcnt(0)\n\ts_barrier" ::: "memory")
#define INIT3(P, t) do { const int k0_ = (t) * KVBLK + 32 * vh; \
    if (k0_ + 31 - qw0 <= -559 || k0_ - qw0 - 31 >= 559) { const float cc_ = ((k0_ < qw0) ? cL : cR) - m_reg; _Pragma("unroll") for (int r = 0; r < 16; ++r) P[r] = cc_; } \
    else { const float* tp_ = tab + (k0_ - qrow + 1024 + 4 * hi); _Pragma("unroll") for (int r = 0; r < 16; ++r) P[r] = tp_[(r & 3) + 8 * (r >> 2)] - m_reg; } } while (0)
#define ROWMAX3(P, xbuf) do { float pmx = P[0]; _Pragma("unroll") for (int r = 1; r < 16; ++r) pmx = fmaxf(pmx, P[r]); \
    auto rr = __builtin_amdgcn_permlane32_swap(__float_as_uint(pmx), __float_as_uint(pmx), false, false); pm_own = fmaxf(__uint_as_float(rr[0]), __uint_as_float(rr[1])); \
    if (hi == 0) xm[(xbuf) * 256 + wid * 32 + r32] = pm_own; } while (0)
#define PACK3(P, B, OUT) do { unsigned a0 = cvtpk(P[B + 0], P[B + 1]), a1 = cvtpk(P[B + 2], P[B + 3]), b0 = cvtpk(P[B + 4], P[B + 5]), b1 = cvtpk(P[B + 6], P[B + 7]); \
    auto r0 = __builtin_amdgcn_permlane32_swap(a0, b0, false, false); auto r1 = __builtin_amdgcn_permlane32_swap(a1, b1, false, false); \
    u32x4 w = {r0[0], r1[0], r0[1], r1[1]}; OUT = *reinterpret_cast<bf16x8*>(&w); } while (0)
#define STAGE3(j, PC, PN, EV, FIRST_, LAST_) do { \
    if (!(LAST_) && (j) + 2 < NT) DMA_K((j) + 2, (EV) ? 0 : 1); \
    DMA_V((j), (EV) ? 0 : 1); \
    bf16x8 qX, qY; if (!(FIRST_)) { qX = *(const bf16x8*)(xp + ((EV) ? 1 : 0) * 16384 + (wid ^ 1) * 2048 + lane * 32); qY = *(const bf16x8*)(xp + ((EV) ? 1 : 0) * 16384 + (wid ^ 1) * 2048 + lane * 32 + 16); } \
    const float pmx_ = fmaxf(pm_own, xm[((EV) ? 0 : 1) * 256 + (wid ^ 1) * 32 + r32]); float alpha = 1.f; \
    if (FIRST_) { m_reg = pmx_; _Pragma("unroll") for (int r = 0; r < 16; ++r) PC[r] -= pmx_; } \
    else if (!__builtin_expect(__all(pmx_ <= THR2), 1)) { const float dl = fmaxf(pmx_, 0.f); m_reg += dl; alpha = __builtin_amdgcn_exp2f(-dl); _Pragma("unroll") for (int r = 0; r < 16; ++r) PC[r] -= dl; } \
    if (!(LAST_)) { INIT3(PN, (j) + 1); \
      const char* kb_ = K_lds + ((EV) ? 1 : 0) * KBUF; \
      _Pragma("unroll") for (int d0 = 0; d0 < 8; ++d0) { const int cb = (d0 * 16 + hi * 8) * 2; \
        const bf16x8 bk = *reinterpret_cast<const bf16x8*>(kb_ + KSWZ(32 * vh + r32, cb)); PN = __builtin_amdgcn_mfma_f32_32x32x16_bf16(bk, qr[d0], PN, 0, 0, 0); \
        PC[2 * d0] = __builtin_amdgcn_exp2f(PC[2 * d0]); PC[2 * d0 + 1] = __builtin_amdgcn_exp2f(PC[2 * d0 + 1]); } } \
    else { _Pragma("unroll") for (int r = 0; r < 16; ++r) PC[r] = __builtin_amdgcn_exp2f(PC[r]); } \
    { bf16x8 a0_, a1_, a2_, a3_; const int vbb_ = vb0 + ((EV) ? 1 : 0) * VBUF; \
      if (!(FIRST_)) { a0_ = vh ? qX : paX; a1_ = vh ? qY : paY; a2_ = vh ? paX : qX; a3_ = vh ? paY : qY; pv_ks<0>(o, vbb_, a0_); } \
      if (!(LAST_)) ROWMAX3(PN, (EV) ? 1 : 0); \
      if (!(FIRST_)) pv_ks<1>(o, vbb_, a1_); \
      { float ps = 0.f; _Pragma("unroll") for (int r = 0; r < 16; ++r) ps += PC[r]; \
        auto rr = __builtin_amdgcn_permlane32_swap(__float_as_uint(ps), __float_as_uint(ps), false, false); ps = __uint_as_float(rr[0]) + __uint_as_float(rr[1]); l_reg = l_reg * alpha + ps; } \
      if (!(FIRST_)) pv_ks<2>(o, vbb_, a2_); \
      PACK3(PC, 0, paX); \
      if (!(FIRST_)) pv_ks<3>(o, vbb_, a3_); \
      PACK3(PC, 8, paY); \
      *(bf16x8*)(xp + ((EV) ? 0 : 1) * 16384 + wid * 2048 + lane * 32) = paX; *(bf16x8*)(xp + ((EV) ? 0 : 1) * 16384 + wid * 2048 + lane * 32 + 16) = paY; } \
    if (__any(alpha < 1.f)) { if (hi == 0) al_l[r32] = alpha; asm volatile("s_waitcnt lgkmcnt(0)" ::: "memory"); \
      _Pragma("unroll") for (int d = 0; d < 4; ++d) _Pragma("unroll") for (int r = 0; r < 16; ++r) o[d][r] *= al_l[crow(r, hi)]; } \
    WAITBAR(); \
  } while (0)
  f32x16 pA, pB; bf16x8 paX, paY;
  DMA_K(0, 0); DMA_K(1, 1); WAITBAR();
  INIT3(pA, 0);
  { const char* kb_ = K_lds;
#pragma unroll
    for (int d0 = 0; d0 < 8; ++d0) { const int cb = (d0 * 16 + hi * 8) * 2; const bf16x8 bk = *reinterpret_cast<const bf16x8*>(kb_ + KSWZ(32 * vh + r32, cb)); pA = __builtin_amdgcn_mfma_f32_32x32x16_bf16(bk, qr[d0], pA, 0, 0, 0); } }
  ROWMAX3(pA, 0);
  WAITBAR();
  STAGE3(0, pA, pB, true, true, false);
#pragma unroll 1
  for (int j = 1; j < NT - 1; j += 2) {
    STAGE3(j, pB, pA, false, false, false);
    STAGE3(j + 1, pA, pB, true, false, false);
  }
  STAGE3(NT - 1, pB, pA, false, false, true);
  { const bf16x8 qX = *(const bf16x8*)(xp + 16384 + (wid ^ 1) * 2048 + lane * 32), qY = *(const bf16x8*)(xp + 16384 + (wid ^ 1) * 2048 + lane * 32 + 16);
    const bf16x8 a0_ = vh ? qX : paX, a1_ = vh ? qY : paY, a2_ = vh ? paX : qX, a3_ = vh ? paY : qY; pv_d0(o, vb0 + VBUF, a0_, a1_, a2_, a3_); }
  asm volatile("s_waitcnt lgkmcnt(0)\n\ts_barrier" ::: "memory");
  l_out = l_reg;
#undef DMA_K
#undef DMA_V
#undef WAITBAR
#undef INIT3
#undef ROWMAX3
#undef PACK3
#undef STAGE3
}
}

constexpr int SEQ = 8192, DM = 2048, DFF = 8192, NLAYER = 4;
constexpr int EV_QKV = 4608, EV_N = 5632  , OD_N = 6144;
constexpr float NORM_EPS = 1e-6f;
constexpr size_t MiB = 1u << 20;
constexpr size_t WS_WIN_E = 0;
constexpr size_t WS_WOUT = 44 * MiB;
constexpr size_t WS_WQKV_O = 76 * MiB;
constexpr size_t WS_WFF1 = 124 * MiB;
constexpr size_t WS_WFF2 = 252 * MiB;
constexpr size_t WS_DFT = 380 * MiB;
constexpr size_t WS_HPM = 508 * MiB;
constexpr size_t WS_H = 636 * MiB;
constexpr size_t WS_CAT = 668 * MiB;
constexpr size_t WS_WCS = 700 * MiB;
constexpr size_t WS_R = 701 * MiB;
constexpr size_t WS_HID = WS_R;
constexpr size_t WS_PROJ = WS_R;
constexpr size_t WS_YT = WS_R + 72 * MiB;
constexpr size_t WS_T = WS_R + 96 * MiB;
constexpr size_t WS_OB = WS_R + 88 * MiB;
constexpr size_t WS_LSE = WS_R + 160 * MiB;
constexpr size_t WS_PART = WS_R + 162 * MiB;
constexpr size_t WS_END = WS_R + 226 * MiB;
constexpr size_t WS_CTL = WS_END;
constexpr size_t WS_DTAB = WS_END + 16384;
constexpr size_t WS_TOTAL = WS_END + 1 * MiB;
constexpr int LDS_BYTES = 147456;
constexpr int XB_LDS_OFF = 147392;

typedef unsigned short bf16r;
typedef unsigned v4u __attribute__((ext_vector_type(4)));
typedef unsigned v2u __attribute__((ext_vector_type(2)));
typedef float f32x4 __attribute__((ext_vector_type(4)));
#define LAS __attribute__((address_space(3)))
__device__ __forceinline__ unsigned f2bf(float f) { unsigned u = __builtin_bit_cast(unsigned, f); return (u + 0x7fffu + ((u >> 16) & 1u)) >> 16; }
__device__ __forceinline__ unsigned pk2(float lo, float hi) { return f2bf(lo) | (f2bf(hi) << 16); }
__device__ __forceinline__ float bf2f(unsigned short b) { return __builtin_bit_cast(float, (unsigned)b << 16); }
__device__ __forceinline__ float wave_sum(float v) {
#pragma unroll
    for (int o = 1; o < 64; o <<= 1) v += __shfl_xor(v, o);
    return v;
}

struct Args { const float* in[17]; float* out; unsigned char* ws; };

struct TJob { int in_idx; int K; int ldw; int ncols; long src_off; long dst_off; int items_end; int qcols; };
#define TJ_ITEMS(K, nc) (((K) / 64) * ((nc) / 32))
__device__ const TJob g_jobs[18] = {
    {5, 2048, 5120, 4608, 0L,                   (long)(WS_WIN_E),              4608, 0},
    {5, 2048, 5120, 4608, 2048L * 5120,         (long)(WS_WIN_E + 22 * MiB),   9216, 0},
    {7, 2048, 2048, 2048, 0L,                   (long)(WS_WOUT),               11264, 0},
    {14, 2048, 2048, 2048, 0L,                  (long)(WS_WOUT + 8 * MiB),     13312, 0},
    {7, 2048, 2048, 2048, 2048L * 2048,         (long)(WS_WOUT + 16 * MiB),    15360, 0},
    {14, 2048, 2048, 2048, 2048L * 2048,        (long)(WS_WOUT + 24 * MiB),    17408, 0},
    {8, 2048, 6144, 6144, 0L,                   (long)(WS_WQKV_O),             23552, 2048},
    {8, 2048, 6144, 6144, 2048L * 6144,         (long)(WS_WQKV_O + 24 * MiB),  29696, 2048},
    {15, 2048, 8192, 8192, 0L,                  (long)(WS_WFF1),               37888, 0},
    {15, 2048, 8192, 8192, 1L * 2048 * 8192,    (long)(WS_WFF1 + 32 * MiB),    46080, 0},
    {15, 2048, 8192, 8192, 2L * 2048 * 8192,    (long)(WS_WFF1 + 64 * MiB),    54272, 0},
    {15, 2048, 8192, 8192, 3L * 2048 * 8192,    (long)(WS_WFF1 + 96 * MiB),    62464, 0},
    {16, 8192, 2048, 2048, 0L,                  (long)(WS_WFF2),               70656, 0},
    {16, 8192, 2048, 2048, 1L * 2048 * 8192,    (long)(WS_WFF2 + 32 * MiB),    78848, 0},
    {16, 8192, 2048, 2048, 2L * 2048 * 8192,    (long)(WS_WFF2 + 64 * MiB),    87040, 0},
    {16, 8192, 2048, 2048, 3L * 2048 * 8192,    (long)(WS_WFF2 + 96 * MiB),    95232, 0},
    {0, 0, 0, 0, 0L, 0L, 95232, 0}, {0, 0, 0, 0, 0L, 0L, 95232, 0}};
constexpr int TJ_TOTAL = 95232, TJ_NJOBS = 16;

__device__ __forceinline__ void transpose_item(const float* W, int ldw, int K, int ncols, bf16r* WT, LAS float* scr, int item, int lane, int qcols) {
    const int nblk = ncols / 32, kb = item / nblk, nb = item % nblk, k0 = 64 * kb, n0 = 32 * nb;
    float tv[32];
#pragma unroll
    for (int i = 0; i < 32; ++i) { const int kk = 2 * i + (lane >> 5); tv[i] = W[(size_t)(k0 + kk) * ldw + n0 + (lane & 31)]; }
    const float wsc = (n0 < qcols) ? att::CL2 : 1.f;
#pragma unroll
    for (int i = 0; i < 32; ++i) { const int kk = 2 * i + (lane >> 5); scr[kk * 33 + (lane & 31)] = tv[i] * wsc; }
    asm volatile("s_waitcnt lgkmcnt(0)" ::: "memory");
    const int c = lane & 7;
#pragma unroll
    for (int j = 0; j < 4; ++j) { const int n = (lane >> 3) + 8 * j; const LAS float* s = scr + (8 * c) * 33 + n;
        v4u o; o.x = pk2(s[0 * 33], s[1 * 33]); o.y = pk2(s[2 * 33], s[3 * 33]); o.z = pk2(s[4 * 33], s[5 * 33]); o.w = pk2(s[6 * 33], s[7 * 33]);
        *(v4u*)(WT + (size_t)(n0 + n) * K + k0 + 8 * c) = o; }
    asm volatile("s_waitcnt lgkmcnt(0)" ::: "memory");
}

template <bool OUTF32>
__device__ __forceinline__ void rms_row(const float* xrow, const float* g, void* orow, int lane) {
    const f32x4* xr = (const f32x4*)xrow + lane; const f32x4* gr = (const f32x4*)g + lane;
    f32x4 v[8]; float s = 0.f;
#pragma unroll
    for (int j = 0; j < 8; ++j) { v[j] = xr[64 * j]; s += (v[j].x * v[j].x + v[j].y * v[j].y) + (v[j].z * v[j].z + v[j].w * v[j].w); }
    const float rstd = 1.f / sqrtf(wave_sum(s) * (1.f / DM) + NORM_EPS);
#pragma unroll
    for (int j = 0; j < 8; ++j) { const f32x4 gg = gr[64 * j]; const f32x4 y = v[j] * rstd * gg;
        if (OUTF32) ((f32x4*)orow)[lane + 64 * j] = y;
        else { v2u w; w.x = pk2(y.x, y.y); w.y = pk2(y.z, y.w); ((v2u*)orow)[lane + 64 * j] = w; } }
}
__device__ __forceinline__ void rms_pair_row(const float* x, const float* g, bf16r* Hh, bf16r* HPM, int t, int lane) {
    const f32x4* xa = (const f32x4*)(x + (size_t)t * DM) + lane; const f32x4* xb = (const f32x4*)(x + (size_t)(t + 4096) * DM) + lane; const f32x4* gr = (const f32x4*)g + lane;
    f32x4 a[8], b[8]; float sa = 0.f, sb = 0.f;
#pragma unroll
    for (int j = 0; j < 8; ++j) { a[j] = xa[64 * j]; b[j] = xb[64 * j]; sa += (a[j].x * a[j].x + a[j].y * a[j].y) + (a[j].z * a[j].z + a[j].w * a[j].w); sb += (b[j].x * b[j].x + b[j].y * b[j].y) + (b[j].z * b[j].z + b[j].w * b[j].w); }
    const float ra = 1.f / sqrtf(wave_sum(sa) * (1.f / DM) + NORM_EPS), rb = 1.f / sqrtf(wave_sum(sb) * (1.f / DM) + NORM_EPS);
#pragma unroll
    for (int j = 0; j < 8; ++j) { const f32x4 gg = gr[64 * j]; const f32x4 ya = a[j] * ra * gg, yb = b[j] * rb * gg, yp = ya + yb, ym = ya - yb; v2u w;
        w.x = pk2(ya.x, ya.y); w.y = pk2(ya.z, ya.w); ((v2u*)(Hh + (size_t)t * DM))[lane + 64 * j] = w;
        w.x = pk2(yb.x, yb.y); w.y = pk2(yb.z, yb.w); ((v2u*)(Hh + (size_t)(t + 4096) * DM))[lane + 64 * j] = w;
        w.x = pk2(yp.x, yp.y); w.y = pk2(yp.z, yp.w); ((v2u*)(HPM + (size_t)t * DM))[lane + 64 * j] = w;
        w.x = pk2(ym.x, ym.y); w.y = pk2(ym.z, ym.w); ((v2u*)(HPM + (size_t)(t + 4096) * DM))[lane + 64 * j] = w; }
}
__device__ __forceinline__ void rms_pair_phase(const float* x, const float* g, bf16r* Hh, bf16r* HPM, int gw, int NGW, int lane) {
    asm volatile("" : "+v"(lane));
#pragma unroll 2
    for (int t = gw; t < SEQ / 2; t += NGW) rms_pair_row(x, g, Hh, HPM, t, lane);
}
template <bool OUTF32>
__device__ __forceinline__ void rms_phase(const float* x, const float* g, void* out, int gw, int NGW, int lane) {
    asm volatile("" : "+v"(lane));
#pragma unroll 2
    for (int m = gw; m < SEQ; m += NGW) rms_row<OUTF32>(x + (size_t)m * DM, g, OUTF32 ? (void*)((float*)out + (size_t)m * DM) : (void*)((bf16r*)out + (size_t)m * DM), lane);
}

__device__ __forceinline__ void diff_attn_unit(int h, int c, int qb, const att::bf16* PROJ, float* T, const float* table, char* lds, bool build_tab) {
    using namespace att3;
    int tid_ = threadIdx.x; asm volatile("" : "+v"(tid_));
    const int tid = tid_, wid = __builtin_amdgcn_readfirstlane(tid >> 6), lane = tid & 63, r32 = lane & 31, hi = lane >> 5, g = wid >> 1;
    float* tab = (float*)(lds + L_TAB);
    constexpr float LOG2E = 1.4426950408889634f;
    __syncthreads();
    if (build_tab) for (int i = tid; i < 2048; i += 512) tab[i] = table[t5_bucket(i - 1024) * 20 + 12 + h] * LOG2E;
    const float cL = table[15 * 20 + 12 + h] * LOG2E, cR = table[31 * 20 + 12 + h] * LOG2E;
    __syncthreads();
    const int q0 = qb * 128, qw0 = q0 + g * 32, qrow = qw0 + r32;
    const bf16* Qw = PROJ + (size_t)qrow * OD_N + h * 256 + c * 128 + hi * 8;
    const bf16* Kh = PROJ + 2048 + h * 256 + c * 128;
    const bf16* Vh = PROJ + 4096 + h * 256;
    f32x16 o[4]; float l;
    attn_core3(Qw, Kh, Vh, (long)OD_N, SEQ / 64, qrow, qw0, tab, cL, cR, lds, o, l);
    {
        int t2 = threadIdx.x; asm volatile("" : "+v"(t2));
        const int wid2 = __builtin_amdgcn_readfirstlane(t2 >> 6), lane2 = t2 & 63, r2 = lane2 & 31, hi2 = lane2 >> 5;
        float* xm = (float*)(lds + L_XM); float* li_l = (float*)(lds + L_WS) + wid2 * 64;
        if (hi2 == 0) xm[wid2 * 32 + r2] = l;
        __syncthreads();
        if (hi2 == 0) li_l[r2] = l + xm[(wid2 ^ 1) * 32 + r2];
        asm volatile("s_waitcnt lgkmcnt(0)" ::: "memory");
        float* Tw = T + (size_t)c * SEQ * DM + (size_t)(qb * 128 + (wid2 >> 1) * 32 + 4 * hi2) * DM + h * 256 + (wid2 & 1) * 128 + r2;
#pragma unroll
        for (int r = 0; r < 16; ++r) { const float rl = __builtin_amdgcn_rcpf(li_l[crow(r, hi2)]); float* Tr = Tw + (size_t)((r & 3) + 8 * (r >> 2)) * DM;
#pragma unroll
            for (int d0 = 0; d0 < 4; ++d0) Tr[d0 * 32] = o[d0][r] * rl; }
        __syncthreads();
    }
}
__device__ __forceinline__ void diff_post_row(const float* T, bf16r* CAT, const float* subg, float lam, float post, int m, int lane) {
    const f32x4* t0 = (const f32x4*)(T + (size_t)m * DM) + lane; const f32x4* t1 = (const f32x4*)(T + (size_t)SEQ * DM + (size_t)m * DM) + lane;
#pragma unroll
    for (int hh = 0; hh < 8; ++hh) {
        const f32x4 a = t0[64 * hh], b = t1[64 * hh]; const f32x4 d = a - b * lam;
        const float ss = wave_sum((d.x * d.x + d.y * d.y) + (d.z * d.z + d.w * d.w));
        const float sc = post / sqrtf(ss * (1.f / 256.f) + NORM_EPS);
        const f32x4 gg = *((const f32x4*)subg + lane); const f32x4 y = d * sc * gg;
        v2u w; w.x = pk2(y.x, y.y); w.y = pk2(y.z, y.w); *((v2u*)(CAT + (size_t)m * DM + 256 * hh) + lane) = w;
    }
}

__device__ __forceinline__ void diff_post_block(const float* T, bf16r* CAT, const float* subg, float lam, float post, int h, int qb) {
    int t_ = threadIdx.x; asm volatile("" : "+v"(t_));
    const int wid = __builtin_amdgcn_readfirstlane(t_ >> 6), lane = t_ & 63;
    asm volatile("s_waitcnt vmcnt(0)" ::: "memory"); __syncthreads();
    const f32x4 gg = *((const f32x4*)subg + lane);
    const float* t0 = T + ((size_t)qb * 128 + wid * 16) * DM + h * 256 + 4 * lane; const float* t1 = t0 + (size_t)SEQ * DM;
    bf16r* cw = CAT + ((size_t)qb * 128 + wid * 16) * DM + h * 256 + 4 * lane;
#pragma unroll 4
    for (int i = 0; i < 16; ++i) {
        const f32x4 a = *(const f32x4*)(t0 + (size_t)i * DM), b = *(const f32x4*)(t1 + (size_t)i * DM); const f32x4 d = a - b * lam;
        const float ss = wave_sum((d.x * d.x + d.y * d.y) + (d.z * d.z + d.w * d.w));
        const float sc = post / sqrtf(ss * (1.f / 256.f) + NORM_EPS); const f32x4 y = d * sc * gg;
        v2u w; w.x = pk2(y.x, y.y); w.y = pk2(y.z, y.w); *(v2u*)(cw + (size_t)i * DM) = w;
    }
}

__device__ __forceinline__ void dil_attn_unit(int head, int br, int cls, int qb, const att::bf16* QKV, bf16r* OB, float* LSE, const float* table, char* lds) {
    using namespace att;
    int tid_ = threadIdx.x; asm volatile("" : "+v"(tid_));
    const int tid = tid_, wid = __builtin_amdgcn_readfirstlane(tid >> 6), lane = tid & 63, r32 = lane & 31, hi = lane >> 5;
    const int dil = br == 0 ? 1 : (br == 1 ? 4 : 16), L = SEQ / dil;
    float* tab = (float*)(lds + LDS_TAB);
    __syncthreads();
    for (int i = tid; i < 640; i += 512) tab[i] = table[(br * 12 + head) * 640 + i];
    __syncthreads();
    const int q0 = qb * 256, qw0 = q0 + wid * 32, qrow = qw0 + r32;
    const bf16* Qw = QKV + ((size_t)qrow * dil + cls) * EV_QKV + head * 128 + hi * 8;
    const bf16* Kh = QKV + (size_t)cls * EV_QKV + 1536 + head * 128;
    const bf16* Vh = QKV + (size_t)cls * EV_QKV + 3072 + head * 128;
    f32x16 o[4]; float l, m;
    attn_core<1>(Qw, Kh, Vh, (long)EV_QKV * dil, q0 - 64, 6, L, qrow, qw0, tab, 320, 0.f, 0.f, lds, o, l, m);
    float* li_l = (float*)(lds + LDS_WS) + wid * 64;
    if (hi == 0) { li_l[r32] = l; LSE[((size_t)br * SEQ + (size_t)qrow * dil + cls) * 12 + head] = m * CL2 + log2f(l); }
    asm volatile("s_waitcnt lgkmcnt(0)" ::: "memory");
    bf16r* Ow = OB + (size_t)br * SEQ * 1536 + head * 128 + r32;
#pragma unroll
    for (int r = 0; r < 16; ++r) { const int orow = crow(r, hi); const float rl = __builtin_amdgcn_rcpf(li_l[orow]); const size_t pos = (size_t)(qw0 + orow) * dil + cls;
#pragma unroll
        for (int d0 = 0; d0 < 4; ++d0) Ow[pos * 1536 + d0 * 32] = (bf16r)f2bf(o[d0][r] * rl); }
    __syncthreads();
}
#define XB_TMO      128
#define XB_XCNT(j)  (256  + 64 * (j))
#define XB_XSUB(j)  (1280 + 64 * (j))
#define XB_XGEN(j)  (2304 + 64 * (j))
#define XB_TOP      3328
#define XB_TOPGEN   3392
#define XCD_BAR_WORDS 3456
#define XB_SPIN_CAP (1u << 22)

__device__ __forceinline__ unsigned xb_ld(unsigned* p)              { return __hip_atomic_load(p, __ATOMIC_RELAXED, __HIP_MEMORY_SCOPE_AGENT); }
__device__ __forceinline__ unsigned xb_add(unsigned* p, unsigned v) { return __hip_atomic_fetch_add(p, v, __ATOMIC_RELAXED, __HIP_MEMORY_SCOPE_AGENT); }
__device__ __forceinline__ unsigned xb_xcc_id() { return (unsigned)__builtin_amdgcn_s_getreg((3 << 11) | 20) & 0xFu; }
#define XB_SPIN(cond, bar) do { unsigned _sp = 0; while (cond) { __builtin_amdgcn_s_sleep(1); \
    if ((++_sp & 255u) == 0u) { if (xb_ld(&(bar)[XB_TMO])) break; if (_sp > XB_SPIN_CAP) { atomicAdd(&(bar)[XB_TMO], 1u); break; } } } } while (0)

struct XcdBarrier {
    unsigned* bar; unsigned x;
    volatile LAS unsigned* st;
};

__device__ __forceinline__ XcdBarrier xcd_barrier_post(unsigned* bar, volatile LAS unsigned* st) {
    XcdBarrier b; b.bar = bar; b.x = xb_xcc_id(); b.st = st;
    if (threadIdx.x == 0) (void)xb_add(&bar[XB_XCNT(b.x)], 1u);
    return b;
}
__device__ __forceinline__ void xcd_barrier_complete(unsigned* bar, unsigned x, unsigned& nloc, unsigned& nx) {
    const unsigned G = gridDim.x * gridDim.y * gridDim.z;
    unsigned sum, cnt, mine, sp = 0u;
    for (;;) {
        sum = 0u; cnt = 0u; mine = 0u;
#pragma unroll
        for (unsigned j = 0; j < 16; ++j) { const unsigned c = xb_ld(&bar[XB_XCNT(j)]); sum += c; cnt += (c > 0u) ? 1u : 0u; mine = (j == x) ? c : mine; }
        if (sum == G) break;
        __builtin_amdgcn_s_sleep(1);
        if ((++sp & 255u) == 0u) { if (xb_ld(&bar[XB_TMO])) break; if (sp > XB_SPIN_CAP) { atomicAdd(&bar[XB_TMO], 1u); break; } }
    }
    nloc = mine > 0u ? mine : 1u; nx = cnt > 0u ? cnt : 1u;
}

__device__ __forceinline__ void xcd_barrier(const XcdBarrier& b) {
    asm volatile("s_waitcnt vmcnt(0)" ::: "memory");
    __syncthreads();
    if (threadIdx.x == 0) {
        unsigned* bar = b.bar;
        __builtin_amdgcn_s_waitcnt(0);
        unsigned nloc = b.st[0], nx = b.st[1];
        if (nloc == 0u) { xcd_barrier_complete(bar, b.x, nloc, nx); b.st[0] = nloc; b.st[1] = nx; }
        const unsigned old = xb_add(&bar[XB_XSUB(b.x)], 1u);
        const unsigned gen = old / nloc;
        if (old + 1u == (gen + 1u) * nloc) {
            __builtin_amdgcn_fence(__ATOMIC_RELEASE, "agent");
            asm volatile("s_waitcnt vmcnt(0)" ::: "memory");
            const unsigned og = xb_add(&bar[XB_TOP], 1u);
            const unsigned tg = og / nx;
            if (og + 1u == (tg + 1u) * nx) xb_add(&bar[XB_TOPGEN], 1u);
            else XB_SPIN(xb_ld(&bar[XB_TOPGEN]) == tg, bar);
            __builtin_amdgcn_fence(__ATOMIC_ACQUIRE, "agent");
            xb_add(&bar[XB_XGEN(b.x)], 1u);
            asm volatile("s_waitcnt vmcnt(0)" ::: "memory");
        } else {
            XB_SPIN(xb_ld(&bar[XB_XGEN(b.x)]) == gen, bar);
            __builtin_amdgcn_fence(__ATOMIC_ACQUIRE, "agent");
            asm volatile("s_waitcnt vmcnt(0)" ::: "memory");
        }
    }
    __syncthreads();
}

#ifndef PROBE_ATT
#define PROBE_ATT 1
#endif
#ifndef PROBE_P0
#define PROBE_P0 1
#endif
#ifndef PROBE_FF1
#define PROBE_FF1 1
#endif
#ifndef PROBE_DIL
#define PROBE_DIL 1
#endif
#ifndef PROBE_SYNC
#define PROBE_SYNC 1
#endif
#define GSYNC() do { for (int rs_ = 0; rs_ < PROBE_SYNC; ++rs_) { XcdBarrier xb_; xb_.bar = (unsigned*)(args.ws + WS_CTL); xb_.x = xb_xcc_id(); xb_.st = (volatile LAS unsigned*)(ldsl + XB_LDS_OFF); xcd_barrier(xb_); } } while (0)
__global__ void __launch_bounds__(512, 2) mega_fwd(Args args) {
    extern __shared__ __attribute__((aligned(16))) unsigned char lds[];
    cg::grid_group grid = cg::this_grid();
    const int tid = threadIdx.x, lane = tid & 63, wave = __builtin_amdgcn_readfirstlane(tid >> 6);
    const int G = gridDim.x, bx = blockIdx.x;
    const int gw = bx * 8 + wave, NGW = G * 8;
    unsigned char* ws = args.ws;
    LAS unsigned char* ldsl = (LAS unsigned char*)lds;
    const float* x_in = args.in[0]; const float* g_mix = args.in[1]; const float* g_ffn = args.in[2]; const float* g_fin = args.in[3];
    const float* table = args.in[4]; const float* w_in_e = args.in[5]; const float* w_fnet = args.in[6];
    float* out = args.out;
    bf16r* H = (bf16r*)(ws + WS_H); bf16r* CAT = (bf16r*)(ws + WS_CAT); float* WCS = (float*)(ws + WS_WCS);
    bf16r* DFT = (bf16r*)(ws + WS_DFT);
    volatile LAS unsigned* xst = (volatile LAS unsigned*)(ldsl + XB_LDS_OFF);
    if (tid < 2) xst[tid] = 0u;
    unsigned* xwords = (unsigned*)(ws + WS_CTL);
    if (bx == 0) for (int i = tid; i < XCD_BAR_WORDS; i += 512) __hip_atomic_store(xwords + i, 0u, __ATOMIC_RELAXED, __HIP_MEMORY_SCOPE_AGENT);
    __syncthreads();
    grid.sync();
    (void)xcd_barrier_post(xwords, xst);

#ifndef SKIP_P0
    for (int rep0_ = 0; rep0_ < PROBE_P0; ++rep0_)
    {
        LAS float* scr = (LAS float*)(ldsl + wave * 16384);
        int jb = 0;
        for (int it = gw; it < TJ_TOTAL; it += NGW) {
            while (it >= g_jobs[jb].items_end) ++jb;
            const TJob J = g_jobs[jb]; const int start = jb == 0 ? 0 : g_jobs[jb - 1].items_end;
            transpose_item(args.in[J.in_idx] + J.src_off, J.ldw, J.K, J.ncols, (bf16r*)(ws + J.dst_off), scr, it - start, lane, J.qcols);
        }
        { float* DT = (float*)(ws + WS_DTAB);
          for (int idx = bx * 512 + tid; idx < 36 * 640; idx += G * 512) { const int hb = idx / 640, i = idx - hb * 640, o = i - 320, br_ = hb / 12, head_ = hb - br_ * 12; const int dil_ = br_ == 0 ? 1 : (br_ == 1 ? 4 : 16);
              DT[idx] = (o >= -64 && o <= 64) ? table[att::t5_bucket(o * dil_) * 20 + head_] * (1.f / att::SCALE) : att::NEGBIG; } }
        for (int idx = bx * 512 + tid; idx < 2 * 4 * 128 * 256; idx += G * 512) {
            const int j = idx & 255, c = (idx >> 8) & 127, lg = idx >> 15, e = j & 127;
            const float* wf = w_fnet + (size_t)lg * 128 * 128 + e; float s = 0.f;
            for (int cp = 0; cp < 128; ++cp) { const float ph = (float)((c * cp) & 127) * (1.f / 128.f); const float tr = (j < 128) ? __builtin_amdgcn_cosf(ph) : __builtin_amdgcn_sinf(ph); s += tr * wf[cp * 128]; }
            WCS[idx] = s * (1.f / 1024.f);
        }
        for (long v = (long)bx * 512 + tid; v < (long)SEQ * 1024; v += (long)G * 512) {
            const int r = (int)(v >> 10), k0 = ((int)v & 1023) * 8; const int sp = ((r & 4095) << 1) | (r >> 12); const bool is_sin = k0 >= 4096; const int kk = k0 & 4095;
            float t[8];
#pragma unroll
            for (int i = 0; i < 8; ++i) { const float ph = (float)((sp * (kk + i)) & 8191) * (1.f / 8192.f); t[i] = is_sin ? -__builtin_amdgcn_sinf(ph) : __builtin_amdgcn_cosf(ph); }
            v4u o; o.x = pk2(t[0], t[1]); o.y = pk2(t[2], t[3]); o.z = pk2(t[4], t[5]); o.w = pk2(t[6], t[7]);
            *(v4u*)(DFT + (size_t)r * 8192 + k0) = o;
        }
        rms_pair_phase(x_in, g_mix, H, (bf16r*)(ws + WS_HPM), gw, NGW, lane);
    }
    GSYNC();
    for (int item = bx; item < 2 * 4 * 32; item += G) {
        const int l = item >> 7, g = (item >> 5) & 3, k0 = (item & 31) * 64;
        LAS float* As = (LAS float*)ldsl;
        __syncthreads();
        for (int i = 0; i < 16; ++i) { const int c = tid & 127, kk = (tid >> 7) + 4 * i; As[c * 68 + kk] = w_in_e[((size_t)l * 2048 + k0 + kk) * 5120 + 4608 + g * 128 + c]; }
        __syncthreads();
        const int j = tid & 255, kh = tid >> 8;
        float acc[32];
#pragma unroll
        for (int i = 0; i < 32; ++i) acc[i] = 0.f;
        const float* wc = WCS + ((size_t)(l * 4 + g) * 128) * 256 + j;
        for (int c = 0; c < 128; ++c) { const float w = wc[c * 256];
#pragma unroll
            for (int q = 0; q < 8; ++q) { const f32x4 a4 = *(const LAS f32x4*)(As + c * 68 + kh * 32 + 4 * q); acc[4 * q] += a4.x * w; acc[4 * q + 1] += a4.y * w; acc[4 * q + 2] += a4.z * w; acc[4 * q + 3] += a4.w * w; } }
        bf16r* dst = (bf16r*)(ws + WS_WIN_E + (size_t)l * 22 * MiB) + (size_t)(4608 + (j >> 7) * 512 + g * 128 + (j & 127)) * 2048 + k0 + kh * 32;
#pragma unroll
        for (int q = 0; q < 4; ++q) { v4u o; o.x = pk2(acc[8 * q], acc[8 * q + 1]); o.y = pk2(acc[8 * q + 2], acc[8 * q + 3]); o.z = pk2(acc[8 * q + 4], acc[8 * q + 5]); o.w = pk2(acc[8 * q + 6], acc[8 * q + 7]); *(v4u*)(dst + 8 * q) = o; }
    }
    GSYNC();
#endif

#pragma unroll 1
    for (int layer = 0; layer < NLAYER; ++layer) {
        const int lj = layer >> 1; const bool even = (layer & 1) == 0;
        const float* resid_base = (layer == 0) ? x_in : out;
        if (even) {
            const bf16r* WIN = (const bf16r*)(ws + WS_WIN_E + (size_t)lj * 22 * MiB);
            bf16r* QKV = (bf16r*)(ws + WS_PROJ); bf16r* YT = (bf16r*)(ws + WS_YT);
            { pg8::Gemm g{H, WIN, DM, DM, DM}; pg8::Order S; S.init(SEQ, EV_QKV, 1, G, bx);
              pg8::EpiBf16<0, false> E{QKV, EV_QKV, 0};
#ifndef SKIP_G0
              pg8::gemm_phase<pg8::EpiBf16<0, false>, pg8::Order, true, true>(ldsl, g, S, E);
#endif
            }
            { pg8::Gemm g{WIN + (size_t)EV_QKV * DM, (const bf16r*)(ws + WS_HPM), DM, DM, DM}; pg8::Order S; S.init(1024, SEQ, 1, G, (bx + G / 2) % G);
              pg8::EpiBf16<0, true> E{YT, 16384, 4096};
#ifndef SKIP_G1
              pg8::gemm_phase<pg8::EpiBf16<0, true>, pg8::Order, true, true>(ldsl, g, S, E);
#endif
            }
            GSYNC();
            { pg8::Gemm g{DFT, YT, 8192, 16384, 2048, 16, 8192}; pg8::Order S; S.init(SEQ, 512, 4, G, bx);
              pg8::EpiPart E{(bf16r*)(ws + WS_PART), 512, (size_t)SEQ * 512};
#ifndef SKIP_G2
              pg8::gemm_phase<pg8::EpiPart, pg8::Order, true, true>(ldsl, g, S, E);
#endif
            }
            for (int rep2_ = 0; rep2_ < PROBE_DIL; ++rep2_)
            for (int u = bx; u < 12 * 3 * 32; u += G) {
                const int qbc = u & 31, hb = u >> 5, head = hb % 12, br = hb / 12; const int nqb = br == 0 ? 32 : (br == 1 ? 8 : 2);
#ifndef SKIP_DIL
                dil_attn_unit(head, br, qbc / nqb, qbc % nqb, (const att::bf16*)QKV, (bf16r*)(ws + WS_OB), (float*)(ws + WS_LSE), (const float*)(ws + WS_DTAB), (char*)lds);
#endif
            }
            GSYNC();
            {
                const bf16r* OB = (const bf16r*)(ws + WS_OB); const float* LSE = (const float*)(ws + WS_LSE); const float* PART = (const float*)(ws + WS_PART);
                int lane_m = lane; asm volatile("" : "+v"(lane_m));
#pragma unroll 2
                for (int m = gw; m < SEQ; m += NGW) {
#pragma unroll
                    for (int i = 0; i < 3; ++i) { const int v = lane_m + 64 * i, head = v >> 4;
                        const float l0 = LSE[((size_t)0 * SEQ + m) * 12 + head], l1 = LSE[((size_t)1 * SEQ + m) * 12 + head], l2 = LSE[((size_t)2 * SEQ + m) * 12 + head];
                        const float mx = fmaxf(l0, fmaxf(l1, l2)); float w0 = __builtin_amdgcn_exp2f(l0 - mx), w1 = __builtin_amdgcn_exp2f(l1 - mx), w2 = __builtin_amdgcn_exp2f(l2 - mx);
                        const float inv = 1.f / (w0 + w1 + w2); w0 *= inv; w1 *= inv; w2 *= inv;
                        const v4u a = *(const v4u*)(OB + ((size_t)0 * SEQ + m) * 1536 + v * 8), b = *(const v4u*)(OB + ((size_t)1 * SEQ + m) * 1536 + v * 8), c = *(const v4u*)(OB + ((size_t)2 * SEQ + m) * 1536 + v * 8);
                        v4u o;
#pragma unroll
                        for (int q = 0; q < 4; ++q) { const float lo = w0 * bf2f((unsigned short)(a[q] & 0xffff)) + w1 * bf2f((unsigned short)(b[q] & 0xffff)) + w2 * bf2f((unsigned short)(c[q] & 0xffff));
                            const float hi2 = w0 * bf2f((unsigned short)(a[q] >> 16)) + w1 * bf2f((unsigned short)(b[q] >> 16)) + w2 * bf2f((unsigned short)(c[q] >> 16)); o[q] = pk2(lo, hi2); }
                        *(v4u*)(CAT + (size_t)m * DM + v * 8) = o; }
                    { f32x4 s0 = (f32x4){0.f, 0.f, 0.f, 0.f}, s1 = s0;
#pragma unroll
                      for (int kc = 0; kc < 4; ++kc) { const v4u w = *(const v4u*)((const bf16r*)PART + ((size_t)kc * SEQ + m) * 512 + lane_m * 8);
                          s0 += (f32x4){bf2f((unsigned short)(w.x & 0xffff)), bf2f((unsigned short)(w.x >> 16)), bf2f((unsigned short)(w.y & 0xffff)), bf2f((unsigned short)(w.y >> 16))};
                          s1 += (f32x4){bf2f((unsigned short)(w.z & 0xffff)), bf2f((unsigned short)(w.z >> 16)), bf2f((unsigned short)(w.w & 0xffff)), bf2f((unsigned short)(w.w >> 16))}; }
                      v4u o; o.x = pk2(s0.x, s0.y); o.y = pk2(s0.z, s0.w); o.z = pk2(s1.x, s1.y); o.w = pk2(s1.z, s1.w);
                      *(v4u*)(CAT + (size_t)m * DM + 1536 + lane_m * 8) = o; }
                }
            }
            GSYNC();
        } else {
            const bf16r* WQ = (const bf16r*)(ws + WS_WQKV_O + (size_t)lj * 24 * MiB);
            bf16r* PROJ = (bf16r*)(ws + WS_PROJ);
            { pg8::Gemm g{H, WQ, DM, DM, DM}; pg8::Order S; S.init(SEQ, OD_N, 1, G, bx);
              pg8::EpiBf16<0, false> E{PROJ, OD_N, 0};
#ifndef SKIP_G3
              pg8::gemm_phase<pg8::EpiBf16<0, false>, pg8::Order, true, true>(ldsl, g, S, E);
#endif
            }
            GSYNC();
            const float lambda_init = (layer == 1) ? 0.3555090676f : 0.5560582042f;
            float lam;
            { int lane_p = lane; asm volatile("" : "+v"(lane_p));
              const float* lq1 = args.in[9] + lj * 128; const float* lk1 = args.in[10] + lj * 128; const float* lq2 = args.in[11] + lj * 128; const float* lk2 = args.in[12] + lj * 128;
              const float sa = wave_sum(lq1[lane_p] * lk1[lane_p] + lq1[lane_p + 64] * lk1[lane_p + 64]);
              const float sb = wave_sum(lq2[lane_p] * lk2[lane_p] + lq2[lane_p + 64] * lk2[lane_p + 64]);
              lam = __builtin_bit_cast(float, __builtin_amdgcn_readfirstlane(__builtin_bit_cast(int, expf(sa) - expf(sb) + lambda_init))); }
            const bool fused_post = (G == 256);
            for (int u = bx; u < 1024; u += G) {
#ifndef SKIP_DIFF
                diff_attn_unit(u & 7, u >> 9, (u >> 3) & 63, (const att::bf16*)PROJ, (float*)(ws + WS_T), table, (char*)lds, (u == bx) || (G & 7) != 0);
                if (fused_post && (u >> 9) == 1) diff_post_block((const float*)(ws + WS_T), CAT, args.in[13] + lj * 256, lam, 1.f - lambda_init, u & 7, (u >> 3) & 63);
#endif
            }
            GSYNC();
            if (!fused_post) {
                int lane_p = lane; asm volatile("" : "+v"(lane_p));
#pragma unroll 2
                for (int m = gw; m < SEQ; m += NGW) diff_post_row((const float*)(ws + WS_T), CAT, args.in[13] + lj * 256, lam, 1.f - lambda_init, m, lane_p);
                GSYNC();
            }
        }
        { pg8::Gemm g{CAT, (const bf16r*)(ws + WS_WOUT + (size_t)layer * 8 * MiB), DM, DM, DM}; pg8::Order S; S.init(SEQ, DM, 1, G, bx);
          pg8::EpiRes E{resid_base, out, DM};
#ifndef SKIP_G4
          pg8::gemm_phase<pg8::EpiRes, pg8::Order, true, true>(ldsl, g, S, E);
#endif
            }
        GSYNC();
        rms_phase<false>(out, g_ffn + layer * DM, H, gw, NGW, lane);
        GSYNC();
        for (int rep1_ = 0; rep1_ < PROBE_FF1; ++rep1_) { pg8::Gemm g{H, (const bf16r*)(ws + WS_WFF1 + (size_t)layer * 32 * MiB), DM, DM, DM}; pg8::Order S; S.init(SEQ, DFF, 1, G, bx);
          pg8::EpiBf16<2, false> E{(bf16r*)(ws + WS_HID), DFF, 0};
#ifndef SKIP_G5
          pg8::gemm_phase<pg8::EpiBf16<2, false>, pg8::Order, true, true>(ldsl, g, S, E);
#endif
            }
        GSYNC();
        { pg8::Gemm g{(const bf16r*)(ws + WS_HID), (const bf16r*)(ws + WS_WFF2 + (size_t)layer * 32 * MiB), DFF, DFF, DFF}; pg8::Order S; S.init(SEQ, DM, 1, G, bx);
          pg8::EpiRes E{out, out, DM};
#ifndef SKIP_G6
          pg8::gemm_phase<pg8::EpiRes, pg8::Order, true, true>(ldsl, g, S, E);
#endif
            }
        GSYNC();
        if (layer < NLAYER - 1) { if (layer & 1) rms_pair_phase(out, g_mix + (layer + 1) * DM, H, (bf16r*)(ws + WS_HPM), gw, NGW, lane); else rms_phase<false>(out, g_mix + (layer + 1) * DM, H, gw, NGW, lane); GSYNC(); }
        else rms_phase<true>(out, g_fin, out, gw, NGW, lane);
    }
}

extern "C" void kernel_launch(void* const* d_in, const int* in_sizes, int n_in, void* d_out, int out_size, void* d_ws, size_t ws_size, hipStream_t stream) {
    static int grid = 0;
    if (grid == 0) {
        if (n_in != 17 || out_size != SEQ * DM || ws_size < WS_TOTAL) { fprintf(stderr, "kernel_launch: unexpected shapes: n_in %d out %d ws %zu (need %zu)\n", n_in, out_size, ws_size, (size_t)WS_TOTAL); grid = -1; return; }
        int dev = 0, cus = 0, per_cu = 0;
        (void)hipGetDevice(&dev); (void)hipDeviceGetAttribute(&cus, hipDeviceAttributeMultiprocessorCount, dev);
        if (hipFuncSetAttribute((const void*)mega_fwd, hipFuncAttributeMaxDynamicSharedMemorySize, LDS_BYTES) != hipSuccess) { fprintf(stderr, "kernel_launch: hipFuncSetAttribute failed\n"); grid = -1; return; }
        if (hipOccupancyMaxActiveBlocksPerMultiprocessor(&per_cu, (const void*)mega_fwd, 512, LDS_BYTES) != hipSuccess || per_cu < 1) { fprintf(stderr, "kernel_launch: occupancy query says %d\n", per_cu); per_cu = 1; }
        (void)hipGetLastError();
        grid = cus * per_cu;
    }
    if (grid < 0) return;
    Args a{};
    for (int i = 0; i < 17; ++i) a.in[i] = (const float*)d_in[i];
    a.out = (float*)d_out; a.ws = (unsigned char*)d_ws;
    void* kargs[] = {&a};
    const hipError_t e = hipLaunchCooperativeKernel((const void*)mega_fwd, dim3(grid), dim3(512), kargs, LDS_BYTES, stream);
    if (e != hipSuccess) fprintf(stderr, "kernel_launch: cooperative launch failed: %s (grid %d)\n", hipGetErrorString(e), grid);
}
```

```cpp
#include <hip/hip_runtime.h>
#include <hip/hip_bf16.h>
#include <hip/hip_cooperative_groups.h>
#include <cstdio>
#include <cstdint>
namespace cg = cooperative_groups;

namespace pg8 {
#define PG8_LAS __attribute__((address_space(3)))
typedef unsigned short bf16_t;
typedef short bf16x8 __attribute__((ext_vector_type(8)));
typedef float f32x4 __attribute__((ext_vector_type(4)));
typedef unsigned u32x4 __attribute__((ext_vector_type(4)));
constexpr int BM = 256, BK = 64, HALF = 128, HTB = HALF * BK * 2  , STAGE_BYTES = 8 * HTB, NXCD = 8, WGM = 8;

__host__ __device__ __forceinline__ int lds_byte(int r, int c) { const int st = (r >> 4) * 2 + (c >> 5), rr = r & 15, cc = c & 31, ob = rr * 64 + cc * 2; return st * 1024 + (ob ^ (((ob >> 9) & 1) << 5)); }
__host__ __device__ __forceinline__ void stage_rc(int b, int& R, int& C) { const int st = b / 1024, sb = b % 1024, swz = sb ^ (((sb >> 9) & 1) << 5); R = (st >> 1) * 16 + swz / 64; C = (st & 1) * 32 + (swz % 64) / 2; }
__host__ __device__ __forceinline__ int perm32(int rho) { const int n = rho >> 4, i = rho & 15; return 8 * (i >> 2) + 4 * n + (i & 3); }

struct Unit { int pm, pn, kc; };
struct Gemm { const bf16_t* A; const bf16_t* Bt; int lda, ldb, K; int bsplit_pm = 1 << 30; int bsplit_off = 0; };

struct Order {
    int nM, nN, nK, nwg, tot, G, c;
    __device__ void init(int M, int N, int nK_, int G_, int c_) { nM = M / BM; nN = N / BM; nK = nK_; nwg = nM * nN; tot = nwg * nK; G = G_; c = c_; }
    __device__ bool next(int i, Unit& u) const {
        const long L = (long)i * G + c; if (L >= tot) return false;
        const int kc = (int)(L / nwg); int wgid = (int)(L % nwg);
        { const int q = nwg / NXCD, r = nwg % NXCD, xcd = wgid % NXCD, off = wgid / NXCD; wgid = (xcd < r ? xcd * (q + 1) : r * (q + 1) + (xcd - r) * q) + off; }
        const int nig = WGM * nN, gid = wgid / nig, fm = gid * WGM, gsz = (nM - fm) < WGM ? (nM - fm) : WGM;
        u.pm = fm + ((wgid % nig) % gsz); u.pn = (wgid % nig) / gsz; u.kc = kc; return true;
    }
    __device__ __forceinline__ void a_ready(const Unit&) const {}
    __device__ __forceinline__ void done(const Unit&) const {}
};

__device__ __forceinline__ unsigned cvt_pk_bf16(float lo, float hi) { unsigned r; asm volatile("v_cvt_pk_bf16_f32 %0, %1, %2" : "=v"(r) : "v"(lo), "v"(hi)); return r; }

template <int ACT, bool YSPLIT> struct EpiBf16 {
    static constexpr bool PERM = true, AFTER_DRAIN = false;
    bf16_t* O; int ldc; int ysplit_cols;
    __device__ __forceinline__ void operator()(const f32x4 (&acc)[2][2][4][2], const Unit& u, int wr, int wc, int fr, int fq) const {
        int rowt = u.pm * BM, colt = u.pn * BM;
        if (YSPLIT) { rowt = (u.pm & 1) * BM; colt = (u.pn >> 4) * (2 * ysplit_cols) + (u.pm >> 1) * ysplit_cols + (u.pn & 15) * BM; }
        const int row0 = rowt + wr * 64 + fr; const int col0 = colt + wc * 32 + 8 * fq;
#pragma unroll
        for (int ai = 0; ai < 2; ++ai)
#pragma unroll
            for (int m = 0; m < 4; ++m) { bf16_t* rowp = O + (size_t)(row0 + ai * HALF + m * 16) * ldc + col0;
#pragma unroll
                for (int bj = 0; bj < 2; ++bj) { f32x4 v0 = acc[ai][bj][m][0], v1 = acc[ai][bj][m][1];
                    if (ACT == 2) {
#pragma unroll
                        for (int q = 0; q < 4; ++q) { const float a = fmaxf(v0[q], 0.f), b = fmaxf(v1[q], 0.f); v0[q] = a * a; v1[q] = b * b; } }
                    u32x4 w; w.x = cvt_pk_bf16(v0[0], v0[1]); w.y = cvt_pk_bf16(v0[2], v0[3]); w.z = cvt_pk_bf16(v1[0], v1[1]); w.w = cvt_pk_bf16(v1[2], v1[3]);
                    *(u32x4*)(rowp + bj * HALF) = w; } }
    }
};
struct EpiRes {
    static constexpr bool PERM = true, AFTER_DRAIN = false;
    const float* base; float* out; int ldc;
    __device__ __forceinline__ void operator()(const f32x4 (&acc)[2][2][4][2], const Unit& u, int wr, int wc, int fr, int fq) const {
        const int col0 = u.pn * BM + wc * 32 + 8 * fq;
#pragma unroll
        for (int ai = 0; ai < 2; ++ai)
#pragma unroll
            for (int m = 0; m < 4; ++m) { const size_t off = (size_t)(u.pm * BM + ai * HALF + wr * 64 + m * 16 + fr) * ldc + col0;
#pragma unroll
                for (int bj = 0; bj < 2; ++bj) { const f32x4 b0 = *(const f32x4*)(base + off + bj * HALF), b1 = *(const f32x4*)(base + off + bj * HALF + 4);
                    *(f32x4*)(out + off + bj * HALF) = b0 + acc[ai][bj][m][0]; *(f32x4*)(out + off + bj * HALF + 4) = b1 + acc[ai][bj][m][1]; }
                asm volatile("" ::: "memory"); }
    }
};
struct EpiPart {
    static constexpr bool PERM = true, AFTER_DRAIN = false;
    bf16_t* out; int ldc; size_t kstride;
    __device__ __forceinline__ void operator()(const f32x4 (&acc)[2][2][4][2], const Unit& u, int wr, int wc, int fr, int fq) const {
        const int col0 = u.pn * BM + wc * 32 + 8 * fq; bf16_t* o = out + (size_t)u.kc * kstride;
#pragma unroll
        for (int ai = 0; ai < 2; ++ai)
#pragma unroll
            for (int m = 0; m < 4; ++m) { const int r = u.pm * BM + ai * HALF + wr * 64 + m * 16 + fr; const size_t off = (size_t)(((r & 4095) << 1) | (r >> 12)) * ldc + col0;
#pragma unroll
                for (int bj = 0; bj < 2; ++bj) { const f32x4 v0 = acc[ai][bj][m][0], v1 = acc[ai][bj][m][1];
                    u32x4 w; w.x = cvt_pk_bf16(v0[0], v0[1]); w.y = cvt_pk_bf16(v0[2], v0[3]); w.z = cvt_pk_bf16(v1[0], v1[1]); w.w = cvt_pk_bf16(v1[2], v1[3]);
                    *(u32x4*)(o + off + bj * HALF) = w; } }
    }
};

template <class Epi, class Sched, bool ALIGN_EPI = false, bool SP2 = false>
__device__ __forceinline__ void gemm_phase(PG8_LAS unsigned char* lds, const Gemm g, const Sched& S, const Epi& E) {
    int tid_ = threadIdx.x; asm volatile("" : "+v"(tid_));
    const int tid = tid_, wid = __builtin_amdgcn_readfirstlane(tid >> 6), lane = tid & 63, wr = wid >> 2, wc = wid & 3, fr = lane & 15, fq = lane >> 4;
    const int K = g.K, nt = K / BK;
    unsigned voffA[2], voffB[2];
#pragma unroll
    for (int i = 0; i < 2; ++i) { int R, C; stage_rc(tid * 16 + i * 8192, R, C); const int Rb = Epi::PERM ? ((R & ~31) + perm32(R & 31)) : R;
        voffA[i] = (unsigned)(R * g.lda + C) * 2u; voffB[i] = (unsigned)(Rb * g.ldb + C) * 2u; }
    const size_t kstep = (size_t)(BK * 2);
    const size_t hstepA = (size_t)HALF * g.lda * 2, hstepB = (size_t)HALF * g.ldb * 2;
    const size_t tstepA = 2 * hstepA, tstepB = 2 * hstepB; const size_t ksplit = (size_t)K * 2;
    const unsigned ldsw = (unsigned)wid * 1024u;
    const int aoff = lds_byte(wr * 64 + fr, fq * 8), boff = lds_byte(wc * 32 + fr, fq * 8);
#define PG8_SA(b, h) (((b) * 2 + (h)) * HTB)
#define PG8_SB(b, h) ((4 + (b) * 2 + (h)) * HTB)
#define PG8_STAGE(bufoff, gbase, voff) do { _Pragma("unroll") for (int _i = 0; _i < 2; ++_i) \
        __builtin_amdgcn_global_load_lds((const unsigned*)((const char*)(gbase) + (voff)[_i]), (PG8_LAS unsigned*)(lds + (bufoff) + ldsw + _i * 8192), 16, 0, 0); } while (0)
#define PG8_LDA(dst, b, h) do { _Pragma("unroll") for (int m = 0; m < 4; ++m) _Pragma("unroll") for (int k = 0; k < 2; ++k) dst[m][k] = *(const PG8_LAS bf16x8*)(lds + PG8_SA(b, h) + aoff + m * 2048 + k * 1024); } while (0)
#define PG8_LDB(dst, b, h) do { _Pragma("unroll") for (int n = 0; n < 2; ++n) _Pragma("unroll") for (int k = 0; k < 2; ++k) dst[n][k] = *(const PG8_LAS bf16x8*)(lds + PG8_SB(b, h) + boff + n * 2048 + k * 1024); } while (0)
#define PG8_MMA(ai, bj, At, Bt) do { __builtin_amdgcn_s_setprio(1); _Pragma("unroll") for (int m = 0; m < 4; ++m) _Pragma("unroll") for (int n = 0; n < 2; ++n) _Pragma("unroll") for (int k = 0; k < 2; ++k) \
        acc[ai][bj][m][n] = __builtin_amdgcn_mfma_f32_16x16x32_bf16(Bt[n][k], At[m][k], acc[ai][bj][m][n], 0, 0, 0); __builtin_amdgcn_s_setprio(0); } while (0)
#define PG8_WAIT_V(n) asm volatile("s_waitcnt vmcnt(" #n ")" ::: "memory")
#define PG8_WAIT_L(n) asm volatile("s_waitcnt lgkmcnt(" #n ")" ::: "memory")
#define PG8_BAR __builtin_amdgcn_s_barrier()
#define PG8_SCHED __builtin_amdgcn_sched_barrier(0)
    Unit cur, nxt; int ui = 0;
    if (!S.next(0, cur)) return;
    f32x4 acc[2][2][4][2];
#pragma unroll
    for (int a = 0; a < 2; ++a)
#pragma unroll
        for (int b = 0; b < 2; ++b)
#pragma unroll
            for (int m = 0; m < 4; ++m)
#pragma unroll
                for (int n = 0; n < 2; ++n) acc[a][b][m][n] = (f32x4){0.f, 0.f, 0.f, 0.f};
    bf16x8 At[4][2], B0[2][2], B1[2][2];
    const char* cA = (const char*)g.A + (size_t)cur.pm * tstepA + (size_t)cur.kc * ksplit; const char* cB = (const char*)g.Bt + (size_t)cur.pn * tstepB + (size_t)cur.kc * ksplit + (cur.pm >= g.bsplit_pm ? (size_t)g.bsplit_off * 2 : (size_t)0);
    S.a_ready(cur);
    if constexpr (SP2) {
        PG8_STAGE(PG8_SB(0, 0), cB, voffB); PG8_STAGE(PG8_SB(0, 1), cB + hstepB, voffB); PG8_STAGE(PG8_SA(0, 0), cA, voffA); PG8_STAGE(PG8_SA(0, 1), cA + hstepA, voffA);
        if (wr == 1) PG8_BAR;
        PG8_WAIT_V(2); PG8_BAR;
        PG8_STAGE(PG8_SB(1, 0), cB + kstep, voffB); PG8_STAGE(PG8_SA(1, 0), cA + kstep, voffA); PG8_STAGE(PG8_SB(1, 1), cB + hstepB + kstep, voffB);
        PG8_WAIT_V(6); PG8_BAR;
    } else {
        PG8_STAGE(PG8_SB(0, 0), cB, voffB); PG8_STAGE(PG8_SA(0, 0), cA, voffA); PG8_STAGE(PG8_SB(0, 1), cB + hstepB, voffB); PG8_STAGE(PG8_SA(0, 1), cA + hstepA, voffA);
        if (wr == 1) PG8_BAR;
        PG8_WAIT_V(4); PG8_BAR;
        PG8_STAGE(PG8_SB(1, 0), cB + kstep, voffB); PG8_STAGE(PG8_SA(1, 0), cA + kstep, voffA); PG8_STAGE(PG8_SB(1, 1), cB + hstepB + kstep, voffB);
        PG8_WAIT_V(6); PG8_BAR;
    }
    for (;;) {
        const bool has_next = S.next(ui + 1, nxt);
        const char* nA = has_next ? (const char*)g.A + (size_t)nxt.pm * tstepA + (size_t)nxt.kc * ksplit : cA; const char* nB = has_next ? (const char*)g.Bt + (size_t)nxt.pn * tstepB + (size_t)nxt.kc * ksplit + (nxt.pm >= g.bsplit_pm ? (size_t)g.bsplit_off * 2 : (size_t)0) : cB;
        for (int t = 0; t < nt; t += 2) {
            const bool last = (t == nt - 2);
            const char* a1 = cA + (size_t)(t + 1) * kstep;
            const char* a2 = last ? nA : cA + (size_t)(t + 2) * kstep; const char* b2 = last ? nB : cB + (size_t)(t + 2) * kstep;
            const char* a3 = a2 + kstep; const char* b3 = b2 + kstep;
            if (last && has_next) S.a_ready(nxt);
            if constexpr (SP2) {
            PG8_LDB(B0, 0, 0); PG8_LDB(B1, 0, 1); PG8_SCHED; PG8_LDA(At, 0, 0); PG8_STAGE(PG8_SA(1, 1), a1 + hstepA, voffA);
            PG8_WAIT_V(8); PG8_WAIT_L(0); PG8_BAR; PG8_MMA(0, 0, At, B0); PG8_MMA(0, 1, At, B1); PG8_BAR; PG8_SCHED;
            PG8_LDA(At, 0, 1); PG8_STAGE(PG8_SB(0, 0), b2, voffB); PG8_STAGE(PG8_SB(0, 1), b2 + hstepB, voffB); PG8_STAGE(PG8_SA(0, 0), a2, voffA);
            PG8_WAIT_V(8); PG8_WAIT_L(0); PG8_BAR; PG8_MMA(1, 0, At, B0); PG8_MMA(1, 1, At, B1); PG8_BAR; PG8_SCHED;
            PG8_LDB(B0, 1, 0); PG8_LDB(B1, 1, 1); PG8_SCHED; PG8_LDA(At, 1, 0); PG8_STAGE(PG8_SA(0, 1), a2 + hstepA, voffA);
            PG8_WAIT_V(8); PG8_WAIT_L(0); PG8_BAR; PG8_MMA(0, 0, At, B0); PG8_MMA(0, 1, At, B1); PG8_BAR; PG8_SCHED;
            PG8_LDA(At, 1, 1); PG8_STAGE(PG8_SB(1, 0), b3, voffB); PG8_STAGE(PG8_SB(1, 1), b3 + hstepB, voffB); PG8_STAGE(PG8_SA(1, 0), a3, voffA);
            PG8_WAIT_V(8); PG8_WAIT_L(0); PG8_BAR; PG8_MMA(1, 0, At, B0); PG8_MMA(1, 1, At, B1); PG8_BAR; PG8_SCHED;
            } else {
            PG8_LDB(B0, 0, 0); PG8_SCHED; PG8_LDA(At, 0, 0); PG8_STAGE(PG8_SA(1, 1), a1 + hstepA, voffA);
            PG8_WAIT_L(8); PG8_BAR; PG8_WAIT_L(0); PG8_MMA(0, 0, At, B0); PG8_BAR; PG8_SCHED;
            PG8_LDB(B1, 0, 1); PG8_STAGE(PG8_SB(0, 0), b2, voffB);
            PG8_BAR; PG8_WAIT_L(0); PG8_MMA(0, 1, At, B1); PG8_BAR;
            PG8_LDA(At, 0, 1); PG8_STAGE(PG8_SA(0, 0), a2, voffA);
            PG8_BAR; PG8_WAIT_L(0); PG8_MMA(1, 0, At, B0); PG8_BAR; PG8_SCHED;
            PG8_STAGE(PG8_SB(0, 1), b2 + hstepB, voffB);
            PG8_WAIT_V(6); PG8_BAR; PG8_MMA(1, 1, At, B1); PG8_BAR;
            PG8_LDB(B0, 1, 0); PG8_SCHED; PG8_LDA(At, 1, 0); PG8_STAGE(PG8_SA(0, 1), a2 + hstepA, voffA);
            PG8_WAIT_L(8); PG8_BAR; PG8_WAIT_L(0); PG8_MMA(0, 0, At, B0); PG8_BAR; PG8_SCHED;
            PG8_LDB(B1, 1, 1); PG8_STAGE(PG8_SB(1, 0), b3, voffB);
            PG8_BAR; PG8_WAIT_L(0); PG8_MMA(0, 1, At, B1); PG8_BAR;
            PG8_LDA(At, 1, 1); PG8_STAGE(PG8_SA(1, 0), a3, voffA);
            PG8_BAR; PG8_WAIT_L(0); PG8_MMA(1, 0, At, B0); PG8_BAR; PG8_SCHED;
            PG8_STAGE(PG8_SB(1, 1), b3 + hstepB, voffB);
            PG8_WAIT_V(6); PG8_BAR; PG8_MMA(1, 1, At, B1); PG8_BAR;
            }
        }
        if constexpr (ALIGN_EPI) { if (wr == 0) PG8_BAR; }
        if constexpr (!Epi::AFTER_DRAIN) { E(acc, cur, wr, wc, fr, fq); S.done(cur); }
        if (!has_next) break;
#pragma unroll
        for (int a = 0; a < 2; ++a)
#pragma unroll
            for (int b = 0; b < 2; ++b)
#pragma unroll
                for (int m = 0; m < 4; ++m)
#pragma unroll
                    for (int n = 0; n < 2; ++n) acc[a][b][m][n] = (f32x4){0.f, 0.f, 0.f, 0.f};
        cur = nxt; cA = nA; cB = nB; ++ui;
        if constexpr (ALIGN_EPI) { if (wr == 1) PG8_BAR; }
    }
    PG8_WAIT_V(0);
    if constexpr (!ALIGN_EPI) { if (wr == 0) PG8_BAR; }
    PG8_BAR;
    if constexpr (Epi::AFTER_DRAIN) { E.fused(acc, cur, wr, wc, fr, fq, lds, wid, lane); S.done(cur); }
#undef PG8_SA
#undef PG8_SB
#undef PG8_STAGE
#undef PG8_LDA
#undef PG8_LDB
#undef PG8_MMA
#undef PG8_WAIT_V
#undef PG8_WAIT_L
#undef PG8_BAR
#undef PG8_SCHED
}
}
namespace att {
using bf16 = __hip_bfloat16;
constexpr int   D = 128, NW = 8, QBLK = 32, KVBLK = 64;
constexpr float SCALE = 0.088388347648318440f;
constexpr float THR = 8.f;
constexpr float CL2 = SCALE * 1.4426950408889634f;
constexpr float NEGBIG = -3.0e38f;
constexpr int SHM_V = KVBLK * D * 2, SHM_K = KVBLK * D * 2;
constexpr int LDS_WS = 2 * SHM_V + 2 * SHM_K, LDS_TAB = LDS_WS + NW * 64 * 4, TAB_FLOATS = 2048, LDS_ATT_END = LDS_TAB + TAB_FLOATS * 4;
using bf16x8 = __attribute__((ext_vector_type(8))) short;
using s16x4  = __attribute__((ext_vector_type(4))) short;
using f32x16 = __attribute__((ext_vector_type(16))) float;
using f32x8  = __attribute__((ext_vector_type(8))) float;
using u32x4  = __attribute__((ext_vector_type(4))) unsigned;
#define KSWZ(row, colB) ((row) * 256 + ((colB) ^ (((row) & 7) << 4)))
#define SBAR() __builtin_amdgcn_sched_barrier(0)
__device__ __forceinline__ int crow(int r, int hi) { return (r & 3) + 8 * (r >> 2) + 4 * hi; }
__device__ __forceinline__ unsigned cvtpk(float lo, float hi) {
  unsigned r; asm volatile("v_cvt_pk_bf16_f32 %0, %1, %2" : "=v"(r) : "v"(lo), "v"(hi)); return r;
}
template <typename TIn> struct Stage;
template <> struct Stage<bf16>  { using T = bf16x8;
  __device__ static __forceinline__ T ld8(const bf16* p) { return *reinterpret_cast<const bf16x8*>(p); }
  __device__ static __forceinline__ bf16x8 tobf(T x) { return x; } };
template <> struct Stage<float> { using T = f32x8;
  __device__ static __forceinline__ T ld8(const float* p) { return *reinterpret_cast<const f32x8*>(p); }
  __device__ static __forceinline__ bf16x8 tobf(T x) {
    u32x4 w = {cvtpk(x[0], x[1]), cvtpk(x[2], x[3]), cvtpk(x[4], x[5]), cvtpk(x[6], x[7])}; return *reinterpret_cast<bf16x8*>(&w); } };

__device__ __forceinline__ void partialSM(f32x16& p0, f32x16& p1, float& m_reg, float& mn, float& alpha) {
  constexpr float C = SCALE * 1.4426950408889634f;
  float pmax = p0[0]; for (int r = 1; r < 16; ++r) pmax = fmaxf(pmax, p0[r]); for (int r = 0; r < 16; ++r) pmax = fmaxf(pmax, p1[r]);
  { auto rr = __builtin_amdgcn_permlane32_swap(__float_as_uint(pmax), __float_as_uint(pmax), false, false);
    pmax = fmaxf(__uint_as_float(rr[0]), __uint_as_float(rr[1])); }
  if (__builtin_expect(__all(pmax - m_reg <= THR / SCALE), 1)) { mn = m_reg; alpha = 1.f; }
  else { mn = fmaxf(m_reg, pmax); alpha = __builtin_amdgcn_exp2f((m_reg - mn) * C); m_reg = mn; }
  float mnC = -mn * C;
  for (int r = 0; r < 16; ++r) p0[r] = fmaf(p0[r], C, mnC); for (int r = 0; r < 16; ++r) p1[r] = fmaf(p1[r], C, mnC);
  for (int r = 0; r < 16; ++r) p0[r] = __builtin_amdgcn_exp2f(p0[r]);
}
__device__ __forceinline__ void partialSM0(f32x16& p0, f32x16& p1, float& m_reg, float& alpha, const bool first) {
  constexpr float THR2 = THR * 1.4426950408889634f;
  float pmax = p0[0]; for (int r = 1; r < 16; ++r) pmax = fmaxf(pmax, p0[r]); for (int r = 0; r < 16; ++r) pmax = fmaxf(pmax, p1[r]);
  { auto rr = __builtin_amdgcn_permlane32_swap(__float_as_uint(pmax), __float_as_uint(pmax), false, false);
    pmax = fmaxf(__uint_as_float(rr[0]), __uint_as_float(rr[1])); }
  if (!first && __builtin_expect(__all(pmax <= THR2), 1)) { alpha = 1.f; }
  else { const float dl = first ? pmax : fmaxf(pmax, 0.f); m_reg += dl; alpha = first ? 1.f : __builtin_amdgcn_exp2f(-dl);
    for (int r = 0; r < 16; ++r) { p0[r] -= dl; p1[r] -= dl; } }
  for (int r = 0; r < 16; ++r) p0[r] = __builtin_amdgcn_exp2f(p0[r]);
}
__device__ __forceinline__ void finishSM(f32x16& p0, f32x16& p1, float alpha, float& l_reg, bf16x8& pa0, bf16x8& pa1, bf16x8& pa2, bf16x8& pa3) {
  for (int r = 0; r < 16; ++r) p1[r] = __builtin_amdgcn_exp2f(p1[r]);
  float ps = 0; for (int r = 0; r < 16; ++r) ps += p0[r]; for (int r = 0; r < 16; ++r) ps += p1[r];
  { auto rr = __builtin_amdgcn_permlane32_swap(__float_as_uint(ps), __float_as_uint(ps), false, false);
    ps = __uint_as_float(rr[0]) + __uint_as_float(rr[1]); }
  l_reg = l_reg * alpha + ps;
#define PK4(P, BASE, OUT) do { unsigned a0 = cvtpk(P[BASE + 0], P[BASE + 1]), a1 = cvtpk(P[BASE + 2], P[BASE + 3]);   \
    unsigned b0 = cvtpk(P[BASE + 4], P[BASE + 5]), b1 = cvtpk(P[BASE + 6], P[BASE + 7]);                              \
    auto r0 = __builtin_amdgcn_permlane32_swap(a0, b0, false, false); auto r1 = __builtin_amdgcn_permlane32_swap(a1, b1, false, false); \
    u32x4 w = {r0[0], r1[0], r0[1], r1[1]}; OUT = *reinterpret_cast<bf16x8*>(&w); } while (0)
  PK4(p0, 0, pa0); PK4(p0, 8, pa1); PK4(p1, 0, pa2); PK4(p1, 8, pa3);
#undef PK4
}
__device__ __forceinline__ void qkt(f32x16& p0, f32x16& p1, const bf16* Ks, const bf16x8* qr, int r32, int hi) {
  for (int d0 = 0; d0 < 8; ++d0) { int cb = (d0 * 16 + hi * 8) * 2;
    bf16x8 b0 = *reinterpret_cast<const bf16x8*>((const char*)Ks + KSWZ(r32, cb));
    bf16x8 b1 = *reinterpret_cast<const bf16x8*>((const char*)Ks + KSWZ(32 + r32, cb));
    p0 = __builtin_amdgcn_mfma_f32_32x32x16_bf16(b0, qr[d0], p0, 0, 0, 0);
    p1 = __builtin_amdgcn_mfma_f32_32x32x16_bf16(b1, qr[d0], p1, 0, 0, 0); }
}
__device__ __forceinline__ int v_st(int k, int c) { const int kk = (k & ~0xC) | ((k & 4) << 1) | ((k & 8) >> 1); return ((kk >> 3) * 4 + (c >> 5)) * 512 + ((kk & 7) * 32 + (c & 31)) * 2; }
__device__ __forceinline__ int v_rd_base(int lane) { return ((lane & 3) << 3) | (((lane >> 2) & 3) << 6) | (((lane >> 4) & 1) << 5) | (((lane >> 5) & 1) << 8); }
constexpr int v_rd_off(int d0, int ks, int half) { return d0 * 512 + ks * 4096 + half * 2048; }
template <int OFF> __device__ __forceinline__ s16x4 tr_read(int vb) {
  s16x4 r; asm volatile("ds_read_b64_tr_b16 %0, %1 offset:%2" : "=&v"(r) : "v"(vb), "i"(OFF) : "memory"); return r;
}
template <int D0> __device__ __forceinline__ void pv_one(f32x16& od, int vb, bf16x8 pa0, bf16x8 pa1, bf16x8 pa2, bf16x8 pa3) {
  const s16x4 l0 = tr_read<v_rd_off(D0, 0, 0)>(vb), h0 = tr_read<v_rd_off(D0, 0, 1)>(vb), l1 = tr_read<v_rd_off(D0, 1, 0)>(vb), h1 = tr_read<v_rd_off(D0, 1, 1)>(vb);
  const s16x4 l2 = tr_read<v_rd_off(D0, 2, 0)>(vb), h2 = tr_read<v_rd_off(D0, 2, 1)>(vb), l3 = tr_read<v_rd_off(D0, 3, 0)>(vb), h3 = tr_read<v_rd_off(D0, 3, 1)>(vb);
  asm volatile("s_waitcnt lgkmcnt(0)" ::: "memory"); SBAR();
#define PK(L, H) (bf16x8){L[0], L[1], L[2], L[3], H[0], H[1], H[2], H[3]}
  od = __builtin_amdgcn_mfma_f32_32x32x16_bf16(pa0, PK(l0, h0), od, 0, 0, 0);
  od = __builtin_amdgcn_mfma_f32_32x32x16_bf16(pa1, PK(l1, h1), od, 0, 0, 0);
  od = __builtin_amdgcn_mfma_f32_32x32x16_bf16(pa2, PK(l2, h2), od, 0, 0, 0);
  od = __builtin_amdgcn_mfma_f32_32x32x16_bf16(pa3, PK(l3, h3), od, 0, 0, 0);
#undef PK
}
__device__ __forceinline__ void pv_d0(f32x16* o, int vb, bf16x8 pa0, bf16x8 pa1, bf16x8 pa2, bf16x8 pa3) {
  pv_one<0>(o[0], vb, pa0, pa1, pa2, pa3); pv_one<1>(o[1], vb, pa0, pa1, pa2, pa3); pv_one<2>(o[2], vb, pa0, pa1, pa2, pa3); pv_one<3>(o[3], vb, pa0, pa1, pa2, pa3);
}
template <int KS> __device__ __forceinline__ void pv_ks(f32x16* o, int vb, bf16x8 pa) {
  const s16x4 l0 = tr_read<v_rd_off(0, KS, 0)>(vb), h0 = tr_read<v_rd_off(0, KS, 1)>(vb), l1 = tr_read<v_rd_off(1, KS, 0)>(vb), h1 = tr_read<v_rd_off(1, KS, 1)>(vb);
  const s16x4 l2 = tr_read<v_rd_off(2, KS, 0)>(vb), h2 = tr_read<v_rd_off(2, KS, 1)>(vb), l3 = tr_read<v_rd_off(3, KS, 0)>(vb), h3 = tr_read<v_rd_off(3, KS, 1)>(vb);
  asm volatile("s_waitcnt lgkmcnt(0)" ::: "memory"); SBAR();
#define PK(L, H) (bf16x8){L[0], L[1], L[2], L[3], H[0], H[1], H[2], H[3]}
  o[0] = __builtin_amdgcn_mfma_f32_32x32x16_bf16(pa, PK(l0, h0), o[0], 0, 0, 0);
  o[1] = __builtin_amdgcn_mfma_f32_32x32x16_bf16(pa, PK(l1, h1), o[1], 0, 0, 0);
  o[2] = __builtin_amdgcn_mfma_f32_32x32x16_bf16(pa, PK(l2, h2), o[2], 0, 0, 0);
  o[3] = __builtin_amdgcn_mfma_f32_32x32x16_bf16(pa, PK(l3, h3), o[3], 0, 0, 0);
#undef PK
}

__device__ __forceinline__ int t5_bucket(int rel) {
  const int base = rel > 0 ? 16 : 0; const int n = rel < 0 ? -rel : rel;
  const int v = n < 8 ? n : (n < 15 ? 8 : (n < 27 ? 9 : (n < 50 ? 10 : (n < 91 ? 11 : (n < 166 ? 12 : (n < 305 ? 13 : (n < 559 ? 14 : 15)))))));
  return base + v;
}

template <int MODE>
__device__ __forceinline__ void attn_core(const bf16* __restrict__ Qw, const bf16* __restrict__ Kh, const bf16* __restrict__ Vh, const long ldk,
                                          const int kbeg, const int NT, const int L, const int qrow, const int qw0,
                                          const float* tab, const int taboff, const float cL, const float cR,
                                          char* lds, f32x16 (&o)[4], float& l_out, float& m_out) {
  using St = Stage<bf16>;
  int tid_ = threadIdx.x; asm volatile("" : "+v"(tid_));
  const int tid = tid_, wid = __builtin_amdgcn_readfirstlane(tid >> 6), lane = tid & 63, r32 = lane & 31, hi = lane >> 5;
  bf16* V_lds = (bf16*)lds; bf16* K_lds = (bf16*)(lds + 2 * SHM_V);
  float* ws = (float*)(lds + LDS_WS) + wid * 64; float* al_l = ws + 32;
  float m_reg = (MODE == 0) ? 0.f : -1e30f, l_reg = 0; bf16x8 qr[8];
#pragma unroll
  for (int d = 0; d < 4; ++d) o[d] = f32x16{};
#pragma unroll
  for (int d0 = 0; d0 < 8; ++d0) qr[d0] = St::ld8(Qw + d0 * 16);
  const int sr = tid >> 4, sc = (tid & 15) * 8, vst0 = v_st(sr, sc), vst1 = v_st(32 + sr, sc);
  const int vb0 = (int)(uintptr_t)V_lds + v_rd_base(lane);
  struct { typename St::T vs0, vs1, ks0, ks1; } sr_[2];
#define CLAMPR(x) ((x) < 0 ? 0 : ((x) > L - 1 ? L - 1 : (x)))
#define SLOAD(i, j) do { const int k0_ = kbeg + (j) * KVBLK; const long ra_ = (long)CLAMPR(k0_ + sr) * ldk + sc, rb_ = (long)CLAMPR(k0_ + 32 + sr) * ldk + sc; \
    sr_[i].vs0 = St::ld8(Vh + ra_); sr_[i].vs1 = St::ld8(Vh + rb_); sr_[i].ks0 = St::ld8(Kh + ra_); sr_[i].ks1 = St::ld8(Kh + rb_); } while (0)
#define SWRITE(b, i) do { *(bf16x8*)((char*)V_lds + (b) * SHM_V + vst0) = St::tobf(sr_[i].vs0);          \
    *(bf16x8*)((char*)V_lds + (b) * SHM_V + vst1) = St::tobf(sr_[i].vs1); int kc = sc * 2;               \
    *(bf16x8*)((char*)K_lds + (b) * SHM_K + KSWZ(sr, kc)) = St::tobf(sr_[i].ks0);                       \
    *(bf16x8*)((char*)K_lds + (b) * SHM_K + KSWZ(32 + sr, kc)) = St::tobf(sr_[i].ks1); } while (0)
#define SWAIT() asm volatile("s_waitcnt vmcnt(4)" ::: "memory")
#define RESC(a) do { if (__any((a) < 1.f)) { if (hi == 0) al_l[r32] = (a); asm volatile("s_waitcnt lgkmcnt(0)" ::: "memory"); \
    for (int d = 0; d < 4; ++d) for (int r = 0; r < 16; ++r) o[d][r] *= al_l[crow(r, hi)]; } } while (0)
#define FILLP(P0, P1, v) do { _Pragma("unroll") for (int r = 0; r < 16; ++r) { P0[r] = (v); P1[r] = (v); } } while (0)
#define LOOKP(P0, P1, k0_) do { const float* tp_ = tab + ((k0_) - qrow + taboff + 4 * hi); \
    _Pragma("unroll") for (int r = 0; r < 16; ++r) { P0[r] = tp_[(r & 3) + 8 * (r >> 2)]; P1[r] = tp_[32 + (r & 3) + 8 * (r >> 2)]; } } while (0)
#ifdef EXP_SIMPLEINIT
#define INIT0(P0, P1, k0_) FILLP(P0, P1, cL)
#else
#define INIT0(P0, P1, k0_) do { if (k0_ + 63 - qw0 <= -559 || k0_ - qw0 - 31 >= 559) { const float cc_ = ((k0_ < qw0) ? cL : cR) - m_reg; FILLP(P0, P1, cc_); } \
    else { LOOKP(P0, P1, k0_); _Pragma("unroll") for (int r = 0; r < 16; ++r) { P0[r] -= m_reg; P1[r] -= m_reg; } } } while (0)
#endif
#define PSM(P0, P1, mn_, al_, first_) do { if (MODE == 0) partialSM0(P0, P1, m_reg, al_, first_); else partialSM(P0, P1, m_reg, mn_, al_); } while (0)
#define INITP(P0, P1, j) do { const int k0_ = kbeg + (j) * KVBLK; \
    if (MODE == 0) { INIT0(P0, P1, k0_); } \
    else { if (k0_ < 0 || k0_ >= L || k0_ - qw0 - 31 > 64 || k0_ + 63 - qw0 < -64) { FILLP(P0, P1, NEGBIG); live_ = false; } else LOOKP(P0, P1, k0_); } } while (0)
  f32x16 pA0, pA1, pB0, pB1; float mnA, mnB, alA, alB; bf16x8 pa0, pa1, pa2, pa3;
  constexpr int SE = 0, SO = 1;
  SLOAD(SE, 0); asm volatile("s_waitcnt vmcnt(0)" ::: "memory"); SWRITE(0, SE); __syncthreads();
  bool live_ = true; INITP(pA0, pA1, 0); if (MODE == 0 || live_) qkt(pA0, pA1, K_lds, qr, r32, hi); PSM(pA0, pA1, mnA, alA, true);
  SLOAD(SO, 1); if (2 < NT) SLOAD(SE, 2);
  SWAIT(); SWRITE(1, SO); __syncthreads();
  for (int j = 1; j + 1 < NT; j += 2) {
    SBAR(); live_ = true; INITP(pB0, pB1, j);
    SBAR(); if (MODE == 0 || live_) qkt(pB0, pB1, (bf16*)((char*)K_lds + SHM_K), qr, r32, hi);
    finishSM(pA0, pA1, alA, l_reg, pa0, pa1, pa2, pa3); SBAR();
    SLOAD(SO, j + 2); SBAR();
    pv_d0(o, vb0, pa0, pa1, pa2, pa3); PSM(pB0, pB1, mnB, alB, false);
    __syncthreads(); SWAIT(); SWRITE(0, SE);
    RESC(alB); __syncthreads();
    SBAR(); live_ = true; INITP(pA0, pA1, j + 1);
    SBAR(); if (MODE == 0 || live_) qkt(pA0, pA1, K_lds, qr, r32, hi);
    finishSM(pB0, pB1, alB, l_reg, pa0, pa1, pa2, pa3); SBAR();
    if (j + 3 < NT) SLOAD(SE, j + 3); SBAR();
    pv_d0(o, vb0 + (int)SHM_V, pa0, pa1, pa2, pa3); PSM(pA0, pA1, mnA, alA, false);
    __syncthreads(); SWAIT(); SWRITE(1, SO);
    RESC(alA); __syncthreads();
  }
  SBAR(); live_ = true; INITP(pB0, pB1, NT - 1);
  SBAR(); if (MODE == 0 || live_) qkt(pB0, pB1, (bf16*)((char*)K_lds + SHM_K), qr, r32, hi);
  finishSM(pA0, pA1, alA, l_reg, pa0, pa1, pa2, pa3); SBAR();
  pv_d0(o, vb0, pa0, pa1, pa2, pa3); PSM(pB0, pB1, mnB, alB, false);
  __syncthreads(); RESC(alB);
  finishSM(pB0, pB1, alB, l_reg, pa0, pa1, pa2, pa3); SBAR();
  pv_d0(o, vb0 + (int)SHM_V, pa0, pa1, pa2, pa3);
  l_out = l_reg; m_out = m_reg;
#undef CLAMPR
#undef SLOAD
#undef SWRITE
#undef SWAIT
#undef RESC
#undef FILLP
#undef LOOKP
#undef INITP
#undef PSM
#undef INIT0
}
}
namespace att3 {
using namespace att;
constexpr int VBUF = 32768, KBUF = 16384;
constexpr int L_V = 0, L_K = 2 * VBUF, L_XM = L_K + 2 * KBUF, L_XP = L_XM + 2048, L_WS = L_XP + 32768, L_TAB = L_WS + 2048, L_END = L_TAB + 8192;
__device__ __forceinline__ void attn_core3(const bf16* __restrict__ Qw, const bf16* __restrict__ Kh, const bf16* __restrict__ Vh, const long ldk, const int NT,
                                           const int qrow, const int qw0, const float* tab, const float cL, const float cR, char* lds, f32x16 (&o)[4], float& l_out) {
  using St = Stage<bf16>;
  constexpr float THR2 = THR * 1.4426950408889634f;
  int tid_ = threadIdx.x; asm volatile("" : "+v"(tid_));
  const int tid = tid_, wid = __builtin_amdgcn_readfirstlane(tid >> 6), lane = tid & 63, r32 = lane & 31, hi = lane >> 5, vh = wid & 1;
  char* V_lds = lds + L_V; char* K_lds = lds + L_K;
  float* xm = (float*)(lds + L_XM); char* xp = lds + L_XP;
  float* al_l = (float*)(lds + L_WS) + wid * 64;
  float m_reg = 0.f, l_reg = 0.f, pm_own; bf16x8 qr[8];
#pragma unroll
  for (int d = 0; d < 4; ++d) o[d] = f32x16{};
#pragma unroll
  for (int d0 = 0; d0 < 8; ++d0) qr[d0] = St::ld8(Qw + d0 * 16);
  const int vb0 = (int)(uintptr_t)V_lds + vh * 16384 + v_rd_base(lane);
  typedef __attribute__((address_space(3))) unsigned lds_u32; typedef __attribute__((address_space(3))) char lds_c;
  lds_c* const kdst = (lds_c*)K_lds + wid * 1024; lds_c* const vdst = (lds_c*)V_lds + wid * 1024;
  const int r8_ = (lane >> 2) & 7;
  const unsigned lk_off = (unsigned)(((lane >> 4) * (int)ldk + (((lane & 15) ^ ((wid * 4 + (lane >> 4)) & 7)) * 8)) * 2);
  const unsigned lv_off = (unsigned)((((r8_ & 3) + 8 * (r8_ >> 2)) * (int)ldk + 32 * (lane >> 5) + 8 * (lane & 3)) * 2);
#define DMA_K(t, kbuf) do { _Pragma("unroll") for (int i = 0; i < 2; ++i) { const char* sb_ = (const char*)Kh + ((long)((t) * KVBLK + wid * 4 + 32 * i) * ldk) * 2; \
      __builtin_amdgcn_global_load_lds((const unsigned*)(sb_ + lk_off), (lds_u32*)(kdst + (kbuf) * KBUF + i * 8192), 16, 0, 0); } } while (0)
#define DMA_V(t, vbuf) do { _Pragma("unroll") for (int i = 0; i < 4; ++i) { const int S_ = (wid >> 1) + 4 * (i & 1); \
      const char* sb_ = (const char*)Vh + ((long)((t) * KVBLK + 16 * (S_ >> 1) + 4 * (S_ & 1)) * ldk + (i >> 1) * 128 + 64 * (wid & 1)) * 2; \
      __builtin_amdgcn_global_load_lds((const unsigned*)(sb_ + lv_off), (lds_u32*)(vdst + (vbuf) * VBUF + i * 8192), 16, 0, 0); } } while (0)
#define WAITBAR() asm volatile("s_waitcnt vmcnt(0) lgkmcnt(0)\n\ts_barrier" ::: "memory")
#define INIT3(P, t) do { const int k0_ = (t) * KVBLK + 32 * vh; \
    if (k0_ + 31 - qw0 <= -559 || k0_ - qw0 - 31 >= 559) { const float cc_ = ((k0_ < qw0) ? cL : cR) - m_reg; _Pragma("unroll") for (int r = 0; r < 16; ++r) P[r] = cc_; } \
    else { const float* tp_ = tab + (k0_ - qrow + 1024 + 4 * hi); _Pragma("unroll") for (int r = 0; r < 16; ++r) P[r] = tp_[(r & 3) + 8 * (r >> 2)] - m_reg; } } while (0)
#define ROWMAX3(P, xbuf) do { float pmx = P[0]; _Pragma("unroll") for (int r = 1; r < 16; ++r) pmx = fmaxf(pmx, P[r]); \
    auto rr = __builtin_amdgcn_permlane32_swap(__float_as_uint(pmx), __float_as_uint(pmx), false, false); pm_own = fmaxf(__uint_as_float(rr[0]), __uint_as_float(rr[1])); \
    if (hi == 0) xm[(xbuf) * 256 + wid * 32 + r32] = pm_own; } while (0)
#define PACK3(P, B, OUT) do { unsigned a0 = cvtpk(P[B + 0], P[B + 1]), a1 = cvtpk(P[B + 2], P[B + 3]), b0 = cvtpk(P[B + 4], P[B + 5]), b1 = cvtpk(P[B + 6], P[B + 7]); \
    auto r0 = __builtin_amdgcn_permlane32_swap(a0, b0, false, false); auto r1 = __builtin_amdgcn_permlane32_swap(a1, b1, false, false); \
    u32x4 w = {r0[0], r1[0], r0[1], r1[1]}; OUT = *reinterpret_cast<bf16x8*>(&w); } while (0)
#define STAGE3(j, PC, PN, EV, FIRST_, LAST_) do { \
    if (!(LAST_) && (j) + 2 < NT) DMA_K((j) + 2, (EV) ? 0 : 1); \
    DMA_V((j), (EV) ? 0 : 1); \
    bf16x8 qX, qY; if (!(FIRST_)) { qX = *(const bf16x8*)(xp + ((EV) ? 1 : 0) * 16384 + (wid ^ 1) * 2048 + lane * 32); qY = *(const bf16x8*)(xp + ((EV) ? 1 : 0) * 16384 + (wid ^ 1) * 2048 + lane * 32 + 16); } \
    const float pmx_ = fmaxf(pm_own, xm[((EV) ? 0 : 1) * 256 + (wid ^ 1) * 32 + r32]); float alpha = 1.f; \
    if (FIRST_) { m_reg = pmx_; _Pragma("unroll") for (int r = 0; r < 16; ++r) PC[r] -= pmx_; } \
    else if (!__builtin_expect(__all(pmx_ <= THR2), 1)) { const float dl = fmaxf(pmx_, 0.f); m_reg += dl; alpha = __builtin_amdgcn_exp2f(-dl); _Pragma("unroll") for (int r = 0; r < 16; ++r) PC[r] -= dl; } \
    if (!(LAST_)) { INIT3(PN, (j) + 1); \
      const char* kb_ = K_lds + ((EV) ? 1 : 0) * KBUF; \
      _Pragma("unroll") for (int d0 = 0; d0 < 8; ++d0) { const int cb = (d0 * 16 + hi * 8) * 2; \
        const bf16x8 bk = *reinterpret_cast<const bf16x8*>(kb_ + KSWZ(32 * vh + r32, cb)); PN = __builtin_amdgcn_mfma_f32_32x32x16_bf16(bk, qr[d0], PN, 0, 0, 0); \
        PC[2 * d0] = __builtin_amdgcn_exp2f(PC[2 * d0]); PC[2 * d0 + 1] = __builtin_amdgcn_exp2f(PC[2 * d0 + 1]); } } \
    else { _Pragma("unroll") for (int r = 0; r < 16; ++r) PC[r] = __builtin_amdgcn_exp2f(PC[r]); } \
    { bf16x8 a0_, a1_, a2_, a3_; const int vbb_ = vb0 + ((EV) ? 1 : 0) * VBUF; \
      if (!(FIRST_)) { a0_ = vh ? qX : paX; a1_ = vh ? qY : paY; a2_ = vh ? paX : qX; a3_ = vh ? paY : qY; pv_ks<0>(o, vbb_, a0_); } \
      if (!(LAST_)) ROWMAX3(PN, (EV) ? 1 : 0); \
      if (!(FIRST_)) pv_ks<1>(o, vbb_, a1_); \
      { float ps = 0.f; _Pragma("unroll") for (int r = 0; r < 16; ++r) ps += PC[r]; \
        auto rr = __builtin_amdgcn_permlane32_swap(__float_as_uint(ps), __float_as_uint(ps), false, false); ps = __uint_as_float(rr[0]) + __uint_as_float(rr[1]); l_reg = l_reg * alpha + ps; } \
      if (!(FIRST_)) pv_ks<2>(o, vbb_, a2_); \
      PACK3(PC, 0, paX); \
      if (!(FIRST_)) pv_ks<3>(o, vbb_, a3_); \
      PACK3(PC, 8, paY); \
      *(bf16x8*)(xp + ((EV) ? 0 : 1) * 16384 + wid * 2048 + lane * 32) = paX; *(bf16x8*)(xp + ((EV) ? 0 : 1) * 16384 + wid * 2048 + lane * 32 + 16) = paY; } \
    if (__any(alpha < 1.f)) { if (hi == 0) al_l[r32] = alpha; asm volatile("s_waitcnt lgkmcnt(0)" ::: "memory"); \
      _Pragma("unroll") for (int d = 0; d < 4; ++d) _Pragma("unroll") for (int r = 0; r < 16; ++r) o[d][r] *= al_l[crow(r, hi)]; } \
    WAITBAR(); \
  } while (0)
  f32x16 pA, pB; bf16x8 paX, paY;
  DMA_K(0, 0); DMA_K(1, 1); WAITBAR();
  INIT3(pA, 0);
  { const char* kb_ = K_lds;
#pragma unroll
    for (int d0 = 0; d0 < 8; ++d0) { const int cb = (d0 * 16 + hi * 8) * 2; const bf16x8 bk = *reinterpret_cast<const bf16x8*>(kb_ + KSWZ(32 * vh + r32, cb)); pA = __builtin_amdgcn_mfma_f32_32x32x16_bf16(bk, qr[d0], pA, 0, 0, 0); } }
  ROWMAX3(pA, 0);
  WAITBAR();
  STAGE3(0, pA, pB, true, true, false);
#pragma unroll 1
  for (int j = 1; j < NT - 1; j += 2) {
    STAGE3(j, pB, pA, false, false, false);
    STAGE3(j + 1, pA, pB, true, false, false);
  }
  STAGE3(NT - 1, pB, pA, false, false, true);
  { const bf16x8 qX = *(const bf16x8*)(xp + 16384 + (wid ^ 1) * 2048 + lane * 32), qY = *(const bf16x8*)(xp + 16384 + (wid ^ 1) * 2048 + lane * 32 + 16);
    const bf16x8 a0_ = vh ? qX : paX, a1_ = vh ? qY : paY, a2_ = vh ? paX : qX, a3_ = vh ? paY : qY; pv_d0(o, vb0 + VBUF, a0_, a1_, a2_, a3_); }
  asm volatile("s_waitcnt lgkmcnt(0)\n\ts_barrier" ::: "memory");
  l_out = l_reg;
#undef DMA_K
#undef DMA_V
#undef WAITBAR
#undef INIT3
#undef ROWMAX3
#undef PACK3
#undef STAGE3
}
}

constexpr int SEQ = 8192, DM = 2048, DFF = 8192, NLAYER = 4;
constexpr int EV_QKV = 4608, EV_N = 5632  , OD_N = 6144;
constexpr float NORM_EPS = 1e-6f;
constexpr size_t MiB = 1u << 20;
constexpr size_t WS_WIN_E = 0;
constexpr size_t WS_WOUT = 44 * MiB;
constexpr size_t WS_WQKV_O = 76 * MiB;
constexpr size_t WS_WFF1 = 124 * MiB;
constexpr size_t WS_WFF2 = 252 * MiB;
constexpr size_t WS_DFT = 380 * MiB;
constexpr size_t WS_HPM = 508 * MiB;
constexpr size_t WS_H = 636 * MiB;
constexpr size_t WS_CAT = 668 * MiB;
constexpr size_t WS_WCS = 700 * MiB;
constexpr size_t WS_R = 701 * MiB;
constexpr size_t WS_HID = WS_R;
constexpr size_t WS_PROJ = WS_R;
constexpr size_t WS_YT = WS_R + 72 * MiB;
constexpr size_t WS_T = WS_R + 96 * MiB;
constexpr size_t WS_OB = WS_R + 88 * MiB;
constexpr size_t WS_LSE = WS_R + 160 * MiB;
constexpr size_t WS_PART = WS_R + 162 * MiB;
constexpr size_t WS_END = WS_R + 226 * MiB;
constexpr size_t WS_CTL = WS_END;
constexpr size_t WS_DTAB = WS_END + 16384;
constexpr size_t WS_TOTAL = WS_END + 1 * MiB;
constexpr int LDS_BYTES = 147456;
constexpr int XB_LDS_OFF = 147392;

typedef unsigned short bf16r;
typedef unsigned v4u __attribute__((ext_vector_type(4)));
typedef unsigned v2u __attribute__((ext_vector_type(2)));
typedef float f32x4 __attribute__((ext_vector_type(4)));
#define LAS __attribute__((address_space(3)))
__device__ __forceinline__ unsigned f2bf(float f) { unsigned u = __builtin_bit_cast(unsigned, f); return (u + 0x7fffu + ((u >> 16) & 1u)) >> 16; }
__device__ __forceinline__ unsigned pk2(float lo, float hi) { return f2bf(lo) | (f2bf(hi) << 16); }
__device__ __forceinline__ float bf2f(unsigned short b) { return __builtin_bit_cast(float, (unsigned)b << 16); }
__device__ __forceinline__ float wave_sum(float v) {
#pragma unroll
    for (int o = 1; o < 64; o <<= 1) v += __shfl_xor(v, o);
    return v;
}

struct Args { const float* in[17]; float* out; unsigned char* ws; };

struct TJob { int in_idx; int K; int ldw; int ncols; long src_off; long dst_off; int items_end; int qcols; };
#define TJ_ITEMS(K, nc) (((K) / 64) * ((nc) / 32))
__device__ const TJob g_jobs[18] = {
    {5, 2048, 5120, 4608, 0L,                   (long)(WS_WIN_E),              4608, 0},
    {5, 2048, 5120, 4608, 2048L * 5120,         (long)(WS_WIN_E + 22 * MiB),   9216, 0},
    {7, 2048, 2048, 2048, 0L,                   (long)(WS_WOUT),               11264, 0},
    {14, 2048, 2048, 2048, 0L,                  (long)(WS_WOUT + 8 * MiB),     13312, 0},
    {7, 2048, 2048, 2048, 2048L * 2048,         (long)(WS_WOUT + 16 * MiB),    15360, 0},
    {14, 2048, 2048, 2048, 2048L * 2048,        (long)(WS_WOUT + 24 * MiB),    17408, 0},
    {8, 2048, 6144, 6144, 0L,                   (long)(WS_WQKV_O),             23552, 2048},
    {8, 2048, 6144, 6144, 2048L * 6144,         (long)(WS_WQKV_O + 24 * MiB),  29696, 2048},
    {15, 2048, 8192, 8192, 0L,                  (long)(WS_WFF1),               37888, 0},
    {15, 2048, 8192, 8192, 1L * 2048 * 8192,    (long)(WS_WFF1 + 32 * MiB),    46080, 0},
    {15, 2048, 8192, 8192, 2L * 2048 * 8192,    (long)(WS_WFF1 + 64 * MiB),    54272, 0},
    {15, 2048, 8192, 8192, 3L * 2048 * 8192,    (long)(WS_WFF1 + 96 * MiB),    62464, 0},
    {16, 8192, 2048, 2048, 0L,                  (long)(WS_WFF2),               70656, 0},
    {16, 8192, 2048, 2048, 1L * 2048 * 8192,    (long)(WS_WFF2 + 32 * MiB),    78848, 0},
    {16, 8192, 2048, 2048, 2L * 2048 * 8192,    (long)(WS_WFF2 + 64 * MiB),    87040, 0},
    {16, 8192, 2048, 2048, 3L * 2048 * 8192,    (long)(WS_WFF2 + 96 * MiB),    95232, 0},
    {0, 0, 0, 0, 0L, 0L, 95232, 0}, {0, 0, 0, 0, 0L, 0L, 95232, 0}};
constexpr int TJ_TOTAL = 95232, TJ_NJOBS = 16;

__device__ __forceinline__ void transpose_item(const float* W, int ldw, int K, int ncols, bf16r* WT, LAS float* scr, int item, int lane, int qcols) {
    const int nblk = ncols / 32, kb = item / nblk, nb = item % nblk, k0 = 64 * kb, n0 = 32 * nb;
    float tv[32];
#pragma unroll
    for (int i = 0; i < 32; ++i) { const int kk = 2 * i + (lane >> 5); tv[i] = W[(size_t)(k0 + kk) * ldw + n0 + (lane & 31)]; }
    const float wsc = (n0 < qcols) ? att::CL2 : 1.f;
#pragma unroll
    for (int i = 0; i < 32; ++i) { const int kk = 2 * i + (lane >> 5); scr[kk * 33 + (lane & 31)] = tv[i] * wsc; }
    asm volatile("s_waitcnt lgkmcnt(0)" ::: "memory");
    const int c = lane & 7;
#pragma unroll
    for (int j = 0; j < 4; ++j) { const int n = (lane >> 3) + 8 * j; const LAS float* s = scr + (8 * c) * 33 + n;
        v4u o; o.x = pk2(s[0 * 33], s[1 * 33]); o.y = pk2(s[2 * 33], s[3 * 33]); o.z = pk2(s[4 * 33], s[5 * 33]); o.w = pk2(s[6 * 33], s[7 * 33]);
        *(v4u*)(WT + (size_t)(n0 + n) * K + k0 + 8 * c) = o; }
    asm volatile("s_waitcnt lgkmcnt(0)" ::: "memory");
}

template <bool OUTF32>
__device__ __forceinline__ void rms_row(const float* xrow, const float* g, void* orow, int lane) {
    const f32x4* xr = (const f32x4*)xrow + lane; const f32x4* gr = (const f32x4*)g + lane;
    f32x4 v[8]; float s = 0.f;
#pragma unroll
    for (int j = 0; j < 8; ++j) { v[j] = xr[64 * j]; s += (v[j].x * v[j].x + v[j].y * v[j].y) + (v[j].z * v[j].z + v[j].w * v[j].w); }
    const float rstd = 1.f / sqrtf(wave_sum(s) * (1.f / DM) + NORM_EPS);
#pragma unroll
    for (int j = 0; j < 8; ++j) { const f32x4 gg = gr[64 * j]; const f32x4 y = v[j] * rstd * gg;
        if (OUTF32) ((f32x4*)orow)[lane + 64 * j] = y;
        else { v2u w; w.x = pk2(y.x, y.y); w.y = pk2(y.z, y.w); ((v2u*)orow)[lane + 64 * j] = w; } }
}
__device__ __forceinline__ void rms_pair_row(const float* x, const float* g, bf16r* Hh, bf16r* HPM, int t, int lane) {
    const f32x4* xa = (const f32x4*)(x + (size_t)t * DM) + lane; const f32x4* xb = (const f32x4*)(x + (size_t)(t + 4096) * DM) + lane; const f32x4* gr = (const f32x4*)g + lane;
    f32x4 a[8], b[8]; float sa = 0.f, sb = 0.f;
#pragma unroll
    for (int j = 0; j < 8; ++j) { a[j] = xa[64 * j]; b[j] = xb[64 * j]; sa += (a[j].x * a[j].x + a[j].y * a[j].y) + (a[j].z * a[j].z + a[j].w * a[j].w); sb += (b[j].x * b[j].x + b[j].y * b[j].y) + (b[j].z * b[j].z + b[j].w * b[j].w); }
    const float ra = 1.f / sqrtf(wave_sum(sa) * (1.f / DM) + NORM_EPS), rb = 1.f / sqrtf(wave_sum(sb) * (1.f / DM) + NORM_EPS);
#pragma unroll
    for (int j = 0; j < 8; ++j) { const f32x4 gg = gr[64 * j]; const f32x4 ya = a[j] * ra * gg, yb = b[j] * rb * gg, yp = ya + yb, ym = ya - yb; v2u w;
        w.x = pk2(ya.x, ya.y); w.y = pk2(ya.z, ya.w); ((v2u*)(Hh + (size_t)t * DM))[lane + 64 * j] = w;
        w.x = pk2(yb.x, yb.y); w.y = pk2(yb.z, yb.w); ((v2u*)(Hh + (size_t)(t + 4096) * DM))[lane + 64 * j] = w;
        w.x = pk2(yp.x, yp.y); w.y = pk2(yp.z, yp.w); ((v2u*)(HPM + (size_t)t * DM))[lane + 64 * j] = w;
        w.x = pk2(ym.x, ym.y); w.y = pk2(ym.z, ym.w); ((v2u*)(HPM + (size_t)(t + 4096) * DM))[lane + 64 * j] = w; }
}
__device__ __forceinline__ void rms_pair_phase(const float* x, const float* g, bf16r* Hh, bf16r* HPM, int gw, int NGW, int lane) {
    asm volatile("" : "+v"(lane));
#pragma unroll 2
    for (int t = gw; t < SEQ / 2; t += NGW) rms_pair_row(x, g, Hh, HPM, t, lane);
}
template <bool OUTF32>
__device__ __forceinline__ void rms_phase(const float* x, const float* g, void* out, int gw, int NGW, int lane) {
    asm volatile("" : "+v"(lane));
#pragma unroll 2
    for (int m = gw; m < SEQ; m += NGW) rms_row<OUTF32>(x + (size_t)m * DM, g, OUTF32 ? (void*)((float*)out + (size_t)m * DM) : (void*)((bf16r*)out + (size_t)m * DM), lane);
}

__device__ __forceinline__ void diff_attn_unit(int h, int c, int qb, const att::bf16* PROJ, float* T, const float* table, char* lds, bool build_tab) {
    using namespace att3;
    int tid_ = threadIdx.x; asm volatile("" : "+v"(tid_));
    const int tid = tid_, wid = __builtin_amdgcn_readfirstlane(tid >> 6), lane = tid & 63, r32 = lane & 31, hi = lane >> 5, g = wid >> 1;
    float* tab = (float*)(lds + L_TAB);
    constexpr float LOG2E = 1.4426950408889634f;
    __syncthreads();
    if (build_tab) for (int i = tid; i < 2048; i += 512) tab[i] = table[t5_bucket(i - 1024) * 20 + 12 + h] * LOG2E;
    const float cL = table[15 * 20 + 12 + h] * LOG2E, cR = table[31 * 20 + 12 + h] * LOG2E;
    __syncthreads();
    const int q0 = qb * 128, qw0 = q0 + g * 32, qrow = qw0 + r32;
    const bf16* Qw = PROJ + (size_t)qrow * OD_N + h * 256 + c * 128 + hi * 8;
    const bf16* Kh = PROJ + 2048 + h * 256 + c * 128;
    const bf16* Vh = PROJ + 4096 + h * 256;
    f32x16 o[4]; float l;
    attn_core3(Qw, Kh, Vh, (long)OD_N, SEQ / 64, qrow, qw0, tab, cL, cR, lds, o, l);
    {
        int t2 = threadIdx.x; asm volatile("" : "+v"(t2));
        const int wid2 = __builtin_amdgcn_readfirstlane(t2 >> 6), lane2 = t2 & 63, r2 = lane2 & 31, hi2 = lane2 >> 5;
        float* xm = (float*)(lds + L_XM); float* li_l = (float*)(lds + L_WS) + wid2 * 64;
        if (hi2 == 0) xm[wid2 * 32 + r2] = l;
        __syncthreads();
        if (hi2 == 0) li_l[r2] = l + xm[(wid2 ^ 1) * 32 + r2];
        asm volatile("s_waitcnt lgkmcnt(0)" ::: "memory");
        bf16r* Tw = (bf16r*)T + (size_t)c * SEQ * DM + (size_t)(qb * 128 + (wid2 >> 1) * 32 + 4 * hi2) * DM + h * 256 + (wid2 & 1) * 128 + r2;
#pragma unroll
        for (int r = 0; r < 16; ++r) { const float rl = __builtin_amdgcn_rcpf(li_l[crow(r, hi2)]); bf16r* Tr = Tw + (size_t)((r & 3) + 8 * (r >> 2)) * DM;
#pragma unroll
            for (int d0 = 0; d0 < 4; ++d0) Tr[d0 * 32] = (bf16r)f2bf(o[d0][r] * rl); }
        __syncthreads();
    }
}
__device__ __forceinline__ void diff_post_row(const float* T, bf16r* CAT, const float* subg, float lam, float post, int m, int lane) {
    const v2u* t0 = (const v2u*)((const bf16r*)T + (size_t)m * DM) + lane; const v2u* t1 = (const v2u*)((const bf16r*)T + (size_t)SEQ * DM + (size_t)m * DM) + lane;
#pragma unroll
    for (int hh = 0; hh < 8; ++hh) {
        const v2u ua = t0[64 * hh], ub = t1[64 * hh];
        const f32x4 a = (f32x4){bf2f((unsigned short)(ua.x & 0xffff)), bf2f((unsigned short)(ua.x >> 16)), bf2f((unsigned short)(ua.y & 0xffff)), bf2f((unsigned short)(ua.y >> 16))};
        const f32x4 b = (f32x4){bf2f((unsigned short)(ub.x & 0xffff)), bf2f((unsigned short)(ub.x >> 16)), bf2f((unsigned short)(ub.y & 0xffff)), bf2f((unsigned short)(ub.y >> 16))};
        const f32x4 d = a - b * lam;
        const float ss = wave_sum((d.x * d.x + d.y * d.y) + (d.z * d.z + d.w * d.w));
        const float sc = post / sqrtf(ss * (1.f / 256.f) + NORM_EPS);
        const f32x4 gg = *((const f32x4*)subg + lane); const f32x4 y = d * sc * gg;
        v2u w; w.x = pk2(y.x, y.y); w.y = pk2(y.z, y.w); *((v2u*)(CAT + (size_t)m * DM + 256 * hh) + lane) = w;
    }
}

__device__ __forceinline__ void diff_post_block(const float* T, bf16r* CAT, const float* subg, float lam, float post, int h, int qb) {
    int t_ = threadIdx.x; asm volatile("" : "+v"(t_));
    const int wid = __builtin_amdgcn_readfirstlane(t_ >> 6), lane = t_ & 63;
    asm volatile("s_waitcnt vmcnt(0)" ::: "memory"); __syncthreads();
    const f32x4 gg = *((const f32x4*)subg + lane);
    const bf16r* t0 = (const bf16r*)T + ((size_t)qb * 128 + wid * 16) * DM + h * 256 + 4 * lane; const bf16r* t1 = t0 + (size_t)SEQ * DM;
    bf16r* cw = CAT + ((size_t)qb * 128 + wid * 16) * DM + h * 256 + 4 * lane;
#pragma unroll 4
    for (int i = 0; i < 16; ++i) {
        const v2u ua = *(const v2u*)(t0 + (size_t)i * DM), ub = *(const v2u*)(t1 + (size_t)i * DM);
        const f32x4 a = (f32x4){bf2f((unsigned short)(ua.x & 0xffff)), bf2f((unsigned short)(ua.x >> 16)), bf2f((unsigned short)(ua.y & 0xffff)), bf2f((unsigned short)(ua.y >> 16))};
        const f32x4 b = (f32x4){bf2f((unsigned short)(ub.x & 0xffff)), bf2f((unsigned short)(ub.x >> 16)), bf2f((unsigned short)(ub.y & 0xffff)), bf2f((unsigned short)(ub.y >> 16))};
        const f32x4 d = a - b * lam;
        const float ss = wave_sum((d.x * d.x + d.y * d.y) + (d.z * d.z + d.w * d.w));
        const float sc = post / sqrtf(ss * (1.f / 256.f) + NORM_EPS); const f32x4 y = d * sc * gg;
        v2u w; w.x = pk2(y.x, y.y); w.y = pk2(y.z, y.w); *(v2u*)(cw + (size_t)i * DM) = w;
    }
}

__device__ __forceinline__ void dil_attn_unit(int head, int br, int cls, int qb, const att::bf16* QKV, bf16r* OB, float* LSE, const float* table, char* lds) {
    using namespace att;
    int tid_ = threadIdx.x; asm volatile("" : "+v"(tid_));
    const int tid = tid_, wid = __builtin_amdgcn_readfirstlane(tid >> 6), lane = tid & 63, r32 = lane & 31, hi = lane >> 5;
    const int dil = br == 0 ? 1 : (br == 1 ? 4 : 16), L = SEQ / dil;
    float* tab = (float*)(lds + LDS_TAB);
    __syncthreads();
    for (int i = tid; i < 640; i += 512) tab[i] = table[(br * 12 + head) * 640 + i];
    __syncthreads();
    const int q0 = qb * 256, qw0 = q0 + wid * 32, qrow = qw0 + r32;
    const bf16* Qw = QKV + ((size_t)qrow * dil + cls) * EV_QKV + head * 128 + hi * 8;
    const bf16* Kh = QKV + (size_t)cls * EV_QKV + 1536 + head * 128;
    const bf16* Vh = QKV + (size_t)cls * EV_QKV + 3072 + head * 128;
    f32x16 o[4]; float l, m;
    attn_core<1>(Qw, Kh, Vh, (long)EV_QKV * dil, q0 - 64, 6, L, qrow, qw0, tab, 320, 0.f, 0.f, lds, o, l, m);
    float* li_l = (float*)(lds + LDS_WS) + wid * 64;
    if (hi == 0) { li_l[r32] = l; LSE[((size_t)br * SEQ + (size_t)qrow * dil + cls) * 12 + head] = m * CL2 + log2f(l); }
    asm volatile("s_waitcnt lgkmcnt(0)" ::: "memory");
    bf16r* Ow = OB + (size_t)br * SEQ * 1536 + head * 128 + r32;
#pragma unroll
    for (int r = 0; r < 16; ++r) { const int orow = crow(r, hi); const float rl = __builtin_amdgcn_rcpf(li_l[orow]); const size_t pos = (size_t)(qw0 + orow) * dil + cls;
#pragma unroll
        for (int d0 = 0; d0 < 4; ++d0) Ow[pos * 1536 + d0 * 32] = (bf16r)f2bf(o[d0][r] * rl); }
    __syncthreads();
}
#define XB_TMO      128
#define XB_XCNT(j)  (256  + 64 * (j))
#define XB_XSUB(j)  (1280 + 64 * (j))
#define XB_XGEN(j)  (2304 + 64 * (j))
#define XB_TOP      3328
#define XB_TOPGEN   3392
#define XCD_BAR_WORDS 3456
#define XB_SPIN_CAP (1u << 22)

__device__ __forceinline__ unsigned xb_ld(unsigned* p)              { return __hip_atomic_load(p, __ATOMIC_RELAXED, __HIP_MEMORY_SCOPE_AGENT); }
__device__ __forceinline__ unsigned xb_add(unsigned* p, unsigned v) { return __hip_atomic_fetch_add(p, v, __ATOMIC_RELAXED, __HIP_MEMORY_SCOPE_AGENT); }
__device__ __forceinline__ unsigned xb_xcc_id() { return (unsigned)__builtin_amdgcn_s_getreg((3 << 11) | 20) & 0xFu; }
#define XB_SPIN(cond, bar) do { unsigned _sp = 0; while (cond) { __builtin_amdgcn_s_sleep(1); \
    if ((++_sp & 255u) == 0u) { if (xb_ld(&(bar)[XB_TMO])) break; if (_sp > XB_SPIN_CAP) { atomicAdd(&(bar)[XB_TMO], 1u); break; } } } } while (0)

struct XcdBarrier {
    unsigned* bar; unsigned x;
    volatile LAS unsigned* st;
};

__device__ __forceinline__ XcdBarrier xcd_barrier_post(unsigned* bar, volatile LAS unsigned* st) {
    XcdBarrier b; b.bar = bar; b.x = xb_xcc_id(); b.st = st;
    if (threadIdx.x == 0) (void)xb_add(&bar[XB_XCNT(b.x)], 1u);
    return b;
}
__device__ __forceinline__ void xcd_barrier_complete(unsigned* bar, unsigned x, unsigned& nloc, unsigned& nx) {
    const unsigned G = gridDim.x * gridDim.y * gridDim.z;
    unsigned sum, cnt, mine, sp = 0u;
    for (;;) {
        sum = 0u; cnt = 0u; mine = 0u;
#pragma unroll
        for (unsigned j = 0; j < 16; ++j) { const unsigned c = xb_ld(&bar[XB_XCNT(j)]); sum += c; cnt += (c > 0u) ? 1u : 0u; mine = (j == x) ? c : mine; }
        if (sum == G) break;
        __builtin_amdgcn_s_sleep(1);
        if ((++sp & 255u) == 0u) { if (xb_ld(&bar[XB_TMO])) break; if (sp > XB_SPIN_CAP) { atomicAdd(&bar[XB_TMO], 1u); break; } }
    }
    nloc = mine > 0u ? mine : 1u; nx = cnt > 0u ? cnt : 1u;
}

__device__ __forceinline__ void xcd_barrier(const XcdBarrier& b) {
    asm volatile("s_waitcnt vmcnt(0)" ::: "memory");
    __syncthreads();
    if (threadIdx.x == 0) {
        unsigned* bar = b.bar;
        __builtin_amdgcn_s_waitcnt(0);
        unsigned nloc = b.st[0], nx = b.st[1];
        if (nloc == 0u) { xcd_barrier_complete(bar, b.x, nloc, nx); b.st[0] = nloc; b.st[1] = nx; }
        const unsigned old = xb_add(&bar[XB_XSUB(b.x)], 1u);
        const unsigned gen = old / nloc;
        if (old + 1u == (gen + 1u) * nloc) {
            __builtin_amdgcn_fence(__ATOMIC_RELEASE, "agent");
            asm volatile("s_waitcnt vmcnt(0)" ::: "memory");
            const unsigned og = xb_add(&bar[XB_TOP], 1u);
            const unsigned tg = og / nx;
            if (og + 1u == (tg + 1u) * nx) xb_add(&bar[XB_TOPGEN], 1u);
            else XB_SPIN(xb_ld(&bar[XB_TOPGEN]) == tg, bar);
            __builtin_amdgcn_fence(__ATOMIC_ACQUIRE, "agent");
            xb_add(&bar[XB_XGEN(b.x)], 1u);
            asm volatile("s_waitcnt vmcnt(0)" ::: "memory");
        } else {
            XB_SPIN(xb_ld(&bar[XB_XGEN(b.x)]) == gen, bar);
            __builtin_amdgcn_fence(__ATOMIC_ACQUIRE, "agent");
            asm volatile("s_waitcnt vmcnt(0)" ::: "memory");
        }
    }
    __syncthreads();
}

#ifndef PROBE_ATT
#define PROBE_ATT 1
#endif
#ifndef PROBE_P0
#define PROBE_P0 1
#endif
#ifndef PROBE_FF1
#define PROBE_FF1 1
#endif
#ifndef PROBE_DIL
#define PROBE_DIL 1
#endif
#ifndef PROBE_SYNC
#define PROBE_SYNC 1
#endif
#define GSYNC() do { for (int rs_ = 0; rs_ < PROBE_SYNC; ++rs_) { XcdBarrier xb_; xb_.bar = (unsigned*)(args.ws + WS_CTL); xb_.x = xb_xcc_id(); xb_.st = (volatile LAS unsigned*)(ldsl + XB_LDS_OFF); xcd_barrier(xb_); } } while (0)
__global__ void __launch_bounds__(512, 2) mega_fwd(Args args) {
    extern __shared__ __attribute__((aligned(16))) unsigned char lds[];
    cg::grid_group grid = cg::this_grid();
    const int tid = threadIdx.x, lane = tid & 63, wave = __builtin_amdgcn_readfirstlane(tid >> 6);
    const int G = gridDim.x, bx = blockIdx.x;
    const int gw = bx * 8 + wave, NGW = G * 8;
    unsigned char* ws = args.ws;
    LAS unsigned char* ldsl = (LAS unsigned char*)lds;
    const float* x_in = args.in[0]; const float* g_mix = args.in[1]; const float* g_ffn = args.in[2]; const float* g_fin = args.in[3];
    const float* table = args.in[4]; const float* w_in_e = args.in[5]; const float* w_fnet = args.in[6];
    float* out = args.out;
    bf16r* H = (bf16r*)(ws + WS_H); bf16r* CAT = (bf16r*)(ws + WS_CAT); float* WCS = (float*)(ws + WS_WCS);
    bf16r* DFT = (bf16r*)(ws + WS_DFT);
    volatile LAS unsigned* xst = (volatile LAS unsigned*)(ldsl + XB_LDS_OFF);
    if (tid < 2) xst[tid] = 0u;
    unsigned* xwords = (unsigned*)(ws + WS_CTL);
    if (bx == 0) for (int i = tid; i < XCD_BAR_WORDS; i += 512) __hip_atomic_store(xwords + i, 0u, __ATOMIC_RELAXED, __HIP_MEMORY_SCOPE_AGENT);
    __syncthreads();
    grid.sync();
    (void)xcd_barrier_post(xwords, xst);

#ifndef SKIP_P0
    for (int rep0_ = 0; rep0_ < PROBE_P0; ++rep0_)
    {
        LAS float* scr = (LAS float*)(ldsl + wave * 16384);
        int jb = 0;
        for (int it = gw; it < TJ_TOTAL; it += NGW) {
            while (it >= g_jobs[jb].items_end) ++jb;
            const TJob J = g_jobs[jb]; const int start = jb == 0 ? 0 : g_jobs[jb - 1].items_end;
            transpose_item(args.in[J.in_idx] + J.src_off, J.ldw, J.K, J.ncols, (bf16r*)(ws + J.dst_off), scr, it - start, lane, J.qcols);
        }
        { float* DT = (float*)(ws + WS_DTAB);
          for (int idx = bx * 512 + tid; idx < 36 * 640; idx += G * 512) { const int hb = idx / 640, i = idx - hb * 640, o = i - 320, br_ = hb / 12, head_ = hb - br_ * 12; const int dil_ = br_ == 0 ? 1 : (br_ == 1 ? 4 : 16);
              DT[idx] = (o >= -64 && o <= 64) ? table[att::t5_bucket(o * dil_) * 20 + head_] * (1.f / att::SCALE) : att::NEGBIG; } }
        for (int idx = bx * 512 + tid; idx < 2 * 4 * 128 * 256; idx += G * 512) {
            const int j = idx & 255, c = (idx >> 8) & 127, lg = idx >> 15, e = j & 127;
            const float* wf = w_fnet + (size_t)lg * 128 * 128 + e; float s = 0.f;
            for (int cp = 0; cp < 128; ++cp) { const float ph = (float)((c * cp) & 127) * (1.f / 128.f); const float tr = (j < 128) ? __builtin_amdgcn_cosf(ph) : __builtin_amdgcn_sinf(ph); s += tr * wf[cp * 128]; }
            WCS[idx] = s * (1.f / 1024.f);
        }
        for (long v = (long)bx * 512 + tid; v < (long)SEQ * 1024; v += (long)G * 512) {
            const int r = (int)(v >> 10), k0 = ((int)v & 1023) * 8; const int sp = ((r & 4095) << 1) | (r >> 12); const bool is_sin = k0 >= 4096; const int kk = k0 & 4095;
            float t[8];
#pragma unroll
            for (int i = 0; i < 8; ++i) { const float ph = (float)((sp * (kk + i)) & 8191) * (1.f / 8192.f); t[i] = is_sin ? -__builtin_amdgcn_sinf(ph) : __builtin_amdgcn_cosf(ph); }
            v4u o; o.x = pk2(t[0], t[1]); o.y = pk2(t[2], t[3]); o.z = pk2(t[4], t[5]); o.w = pk2(t[6], t[7]);
            *(v4u*)(DFT + (size_t)r * 8192 + k0) = o;
        }
        rms_pair_phase(x_in, g_mix, H, (bf16r*)(ws + WS_HPM), gw, NGW, lane);
    }
    GSYNC();
    for (int item = bx; item < 2 * 4 * 32; item += G) {
        const int l = item >> 7, g = (item >> 5) & 3, k0 = (item & 31) * 64;
        LAS float* As = (LAS float*)ldsl;
        __syncthreads();
        for (int i = 0; i < 16; ++i) { const int c = tid & 127, kk = (tid >> 7) + 4 * i; As[c * 68 + kk] = w_in_e[((size_t)l * 2048 + k0 + kk) * 5120 + 4608 + g * 128 + c]; }
        __syncthreads();
        const int j = tid & 255, kh = tid >> 8;
        float acc[32];
#pragma unroll
        for (int i = 0; i < 32; ++i) acc[i] = 0.f;
        const float* wc = WCS + ((size_t)(l * 4 + g) * 128) * 256 + j;
        for (int c = 0; c < 128; ++c) { const float w = wc[c * 256];
#pragma unroll
            for (int q = 0; q < 8; ++q) { const f32x4 a4 = *(const LAS f32x4*)(As + c * 68 + kh * 32 + 4 * q); acc[4 * q] += a4.x * w; acc[4 * q + 1] += a4.y * w; acc[4 * q + 2] += a4.z * w; acc[4 * q + 3] += a4.w * w; } }
        bf16r* dst = (bf16r*)(ws + WS_WIN_E + (size_t)l * 22 * MiB) + (size_t)(4608 + (j >> 7) * 512 + g * 128 + (j & 127)) * 2048 + k0 + kh * 32;
#pragma unroll
        for (int q = 0; q < 4; ++q) { v4u o; o.x = pk2(acc[8 * q], acc[8 * q + 1]); o.y = pk2(acc[8 * q + 2], acc[8 * q + 3]); o.z = pk2(acc[8 * q + 4], acc[8 * q + 5]); o.w = pk2(acc[8 * q + 6], acc[8 * q + 7]); *(v4u*)(dst + 8 * q) = o; }
    }
    GSYNC();
#endif

#pragma unroll 1
    for (int layer = 0; layer < NLAYER; ++layer) {
        const int lj = layer >> 1; const bool even = (layer & 1) == 0;
        const float* resid_base = (layer == 0) ? x_in : out;
        if (even) {
            const bf16r* WIN = (const bf16r*)(ws + WS_WIN_E + (size_t)lj * 22 * MiB);
            bf16r* QKV = (bf16r*)(ws + WS_PROJ); bf16r* YT = (bf16r*)(ws + WS_YT);
            { pg8::Gemm g{H, WIN, DM, DM, DM}; pg8::Order S; S.init(SEQ, EV_QKV, 1, G, bx);
              pg8::EpiBf16<0, false> E{QKV, EV_QKV, 0};
#ifndef SKIP_G0
              pg8::gemm_phase<pg8::EpiBf16<0, false>, pg8::Order, true, true>(ldsl, g, S, E);
#endif
            }
            { pg8::Gemm g{WIN + (size_t)EV_QKV * DM, (const bf16r*)(ws + WS_HPM), DM, DM, DM}; pg8::Order S; S.init(1024, SEQ, 1, G, (bx + G / 2) % G);
              pg8::EpiBf16<0, true> E{YT, 16384, 4096};
#ifndef SKIP_G1
              pg8::gemm_phase<pg8::EpiBf16<0, true>, pg8::Order, true, true>(ldsl, g, S, E);
#endif
            }
            GSYNC();
            { pg8::Gemm g{DFT, YT, 8192, 16384, 2048, 16, 8192}; pg8::Order S; S.init(SEQ, 512, 4, G, bx);
              pg8::EpiPart E{(bf16r*)(ws + WS_PART), 512, (size_t)SEQ * 512};
#ifndef SKIP_G2
              pg8::gemm_phase<pg8::EpiPart, pg8::Order, true, true>(ldsl, g, S, E);
#endif
            }
            for (int rep2_ = 0; rep2_ < PROBE_DIL; ++rep2_)
            for (int u = bx; u < 12 * 3 * 32; u += G) {
                const int qbc = u & 31, hb = u >> 5, head = hb % 12, br = hb / 12; const int nqb = br == 0 ? 32 : (br == 1 ? 8 : 2);
#ifndef SKIP_DIL
                dil_attn_unit(head, br, qbc / nqb, qbc % nqb, (const att::bf16*)QKV, (bf16r*)(ws + WS_OB), (float*)(ws + WS_LSE), (const float*)(ws + WS_DTAB), (char*)lds);
#endif
            }
            GSYNC();
            {
                const bf16r* OB = (const bf16r*)(ws + WS_OB); const float* LSE = (const float*)(ws + WS_LSE); const float* PART = (const float*)(ws + WS_PART);
                int lane_m = lane; asm volatile("" : "+v"(lane_m));
#pragma unroll 2
                for (int m = gw; m < SEQ; m += NGW) {
#pragma unroll
                    for (int i = 0; i < 3; ++i) { const int v = lane_m + 64 * i, head = v >> 4;
                        const float l0 = LSE[((size_t)0 * SEQ + m) * 12 + head], l1 = LSE[((size_t)1 * SEQ + m) * 12 + head], l2 = LSE[((size_t)2 * SEQ + m) * 12 + head];
                        const float mx = fmaxf(l0, fmaxf(l1, l2)); float w0 = __builtin_amdgcn_exp2f(l0 - mx), w1 = __builtin_amdgcn_exp2f(l1 - mx), w2 = __builtin_amdgcn_exp2f(l2 - mx);
                        const float inv = 1.f / (w0 + w1 + w2); w0 *= inv; w1 *= inv; w2 *= inv;
                        const v4u a = *(const v4u*)(OB + ((size_t)0 * SEQ + m) * 1536 + v * 8), b = *(const v4u*)(OB + ((size_t)1 * SEQ + m) * 1536 + v * 8), c = *(const v4u*)(OB + ((size_t)2 * SEQ + m) * 1536 + v * 8);
                        v4u o;
#pragma unroll
                        for (int q = 0; q < 4; ++q) { const float lo = w0 * bf2f((unsigned short)(a[q] & 0xffff)) + w1 * bf2f((unsigned short)(b[q] & 0xffff)) + w2 * bf2f((unsigned short)(c[q] & 0xffff));
                            const float hi2 = w0 * bf2f((unsigned short)(a[q] >> 16)) + w1 * bf2f((unsigned short)(b[q] >> 16)) + w2 * bf2f((unsigned short)(c[q] >> 16)); o[q] = pk2(lo, hi2); }
                        *(v4u*)(CAT + (size_t)m * DM + v * 8) = o; }
                    { f32x4 s0 = (f32x4){0.f, 0.f, 0.f, 0.f}, s1 = s0;
#pragma unroll
                      for (int kc = 0; kc < 4; ++kc) { const v4u w = *(const v4u*)((const bf16r*)PART + ((size_t)kc * SEQ + m) * 512 + lane_m * 8);
                          s0 += (f32x4){bf2f((unsigned short)(w.x & 0xffff)), bf2f((unsigned short)(w.x >> 16)), bf2f((unsigned short)(w.y & 0xffff)), bf2f((unsigned short)(w.y >> 16))};
                          s1 += (f32x4){bf2f((unsigned short)(w.z & 0xffff)), bf2f((unsigned short)(w.z >> 16)), bf2f((unsigned short)(w.w & 0xffff)), bf2f((unsigned short)(w.w >> 16))}; }
                      v4u o; o.x = pk2(s0.x, s0.y); o.y = pk2(s0.z, s0.w); o.z = pk2(s1.x, s1.y); o.w = pk2(s1.z, s1.w);
                      *(v4u*)(CAT + (size_t)m * DM + 1536 + lane_m * 8) = o; }
                }
            }
            GSYNC();
        } else {
            const bf16r* WQ = (const bf16r*)(ws + WS_WQKV_O + (size_t)lj * 24 * MiB);
            bf16r* PROJ = (bf16r*)(ws + WS_PROJ);
            { pg8::Gemm g{H, WQ, DM, DM, DM}; pg8::Order S; S.init(SEQ, OD_N, 1, G, bx);
              pg8::EpiBf16<0, false> E{PROJ, OD_N, 0};
#ifndef SKIP_G3
              pg8::gemm_phase<pg8::EpiBf16<0, false>, pg8::Order, true, true>(ldsl, g, S, E);
#endif
            }
            GSYNC();
            const float lambda_init = (layer == 1) ? 0.3555090676f : 0.5560582042f;
            float lam;
            { int lane_p = lane; asm volatile("" : "+v"(lane_p));
              const float* lq1 = args.in[9] + lj * 128; const float* lk1 = args.in[10] + lj * 128; const float* lq2 = args.in[11] + lj * 128; const float* lk2 = args.in[12] + lj * 128;
              const float sa = wave_sum(lq1[lane_p] * lk1[lane_p] + lq1[lane_p + 64] * lk1[lane_p + 64]);
              const float sb = wave_sum(lq2[lane_p] * lk2[lane_p] + lq2[lane_p + 64] * lk2[lane_p + 64]);
              lam = __builtin_bit_cast(float, __builtin_amdgcn_readfirstlane(__builtin_bit_cast(int, expf(sa) - expf(sb) + lambda_init))); }
            const bool fused_post = (G == 256);
            for (int u = bx; u < 1024; u += G) {
#ifndef SKIP_DIFF
                diff_attn_unit(u & 7, u >> 9, (u >> 3) & 63, (const att::bf16*)PROJ, (float*)(ws + WS_T), table, (char*)lds, (u == bx) || (G & 7) != 0);
                if (fused_post && (u >> 9) == 1) diff_post_block((const float*)(ws + WS_T), CAT, args.in[13] + lj * 256, lam, 1.f - lambda_init, u & 7, (u >> 3) & 63);
#endif
            }
            GSYNC();
            if (!fused_post) {
                int lane_p = lane; asm volatile("" : "+v"(lane_p));
#pragma unroll 2
                for (int m = gw; m < SEQ; m += NGW) diff_post_row((const float*)(ws + WS_T), CAT, args.in[13] + lj * 256, lam, 1.f - lambda_init, m, lane_p);
                GSYNC();
            }
        }
        { pg8::Gemm g{CAT, (const bf16r*)(ws + WS_WOUT + (size_t)layer * 8 * MiB), DM, DM, DM}; pg8::Order S; S.init(SEQ, DM, 1, G, bx);
          pg8::EpiRes E{resid_base, out, DM};
#ifndef SKIP_G4
          pg8::gemm_phase<pg8::EpiRes, pg8::Order, true, true>(ldsl, g, S, E);
#endif
            }
        GSYNC();
        rms_phase<false>(out, g_ffn + layer * DM, H, gw, NGW, lane);
        GSYNC();
        for (int rep1_ = 0; rep1_ < PROBE_FF1; ++rep1_) { pg8::Gemm g{H, (const bf16r*)(ws + WS_WFF1 + (size_t)layer * 32 * MiB), DM, DM, DM}; pg8::Order S; S.init(SEQ, DFF, 1, G, bx);
          pg8::EpiBf16<2, false> E{(bf16r*)(ws + WS_HID), DFF, 0};
#ifndef SKIP_G5
          pg8::gemm_phase<pg8::EpiBf16<2, false>, pg8::Order, true, true>(ldsl, g, S, E);
#endif
            }
        GSYNC();
        { pg8::Gemm g{(const bf16r*)(ws + WS_HID), (const bf16r*)(ws + WS_WFF2 + (size_t)layer * 32 * MiB), DFF, DFF, DFF}; pg8::Order S; S.init(SEQ, DM, 1, G, bx);
          pg8::EpiRes E{out, out, DM};
#ifndef SKIP_G6
          pg8::gemm_phase<pg8::EpiRes, pg8::Order, true, true>(ldsl, g, S, E);
#endif
            }
        GSYNC();
        if (layer < NLAYER - 1) { if (layer & 1) rms_pair_phase(out, g_mix + (layer + 1) * DM, H, (bf16r*)(ws + WS_HPM), gw, NGW, lane); else rms_phase<false>(out, g_mix + (layer + 1) * DM, H, gw, NGW, lane); GSYNC(); }
        else rms_phase<true>(out, g_fin, out, gw, NGW, lane);
    }
}

extern "C" void kernel_launch(void* const* d_in, const int* in_sizes, int n_in, void* d_out, int out_size, void* d_ws, size_t ws_size, hipStream_t stream) {
    static int grid = 0;
    if (grid == 0) {
        if (n_in != 17 || out_size != SEQ * DM || ws_size < WS_TOTAL) { fprintf(stderr, "kernel_launch: unexpected shapes: n_in %d out %d ws %zu (need %zu)\n", n_in, out_size, ws_size, (size_t)WS_TOTAL); grid = -1; return; }
        int dev = 0, cus = 0, per_cu = 0;
        (void)hipGetDevice(&dev); (void)hipDeviceGetAttribute(&cus, hipDeviceAttributeMultiprocessorCount, dev);
        if (hipFuncSetAttribute((const void*)mega_fwd, hipFuncAttributeMaxDynamicSharedMemorySize, LDS_BYTES) != hipSuccess) { fprintf(stderr, "kernel_launch: hipFuncSetAttribute failed\n"); grid = -1; return; }
        if (hipOccupancyMaxActiveBlocksPerMultiprocessor(&per_cu, (const void*)mega_fwd, 512, LDS_BYTES) != hipSuccess || per_cu < 1) { fprintf(stderr, "kernel_launch: occupancy query says %d\n", per_cu); per_cu = 1; }
        (void)hipGetLastError();
        grid = cus * per_cu;
    }
    if (grid < 0) return;
    Args a{};
    for (int i = 0; i < 17; ++i) a.in[i] = (const float*)d_in[i];
    a.out = (float*)d_out; a.ws = (unsigned char*)d_ws;
    void* kargs[] = {&a};
    const hipError_t e = hipLaunchCooperativeKernel((const void*)mega_fwd, dim3(grid), dim3(512), kargs, LDS_BYTES, stream);
    if (e != hipSuccess) fprintf(stderr, "kernel_launch: cooperative launch failed: %s (grid %d)\n", hipGetErrorString(e), grid);
}
```
